# Optimizing an MI355X kernel written in HIP

```python
import math
import jax, jax.numpy as jnp
from jax import lax
import numpy as np

D_MODEL = 2048
BATCH = 16
SEQ = 256
DEPTH = 2
DEC_BATCH = 4
DEC_SEQ = 4096
PAST_LEN = 512

GRID_W = 64
N_EVEN = (DEPTH + 1) // 2
N_ODD = DEPTH // 2
H_A = 8
DH_A = 128
WIN_H = 8
WIN_W = 16
C_B = 1024
CONV_W = 31
H_C = 8
DH_C = 128
D_FF = 5632
N_SUB = 3
N_MOD = 3 * N_SUB
EPS = 1e-6
QBLOCK = 128
ROPE_BASE = 10000.0
W_A = H_A * DH_A
IN_A = 3 * W_A + 2 * C_B
OUT_A = W_A + C_B
IN_C = 2 * (2 * H_C * DH_C) + H_C * 2 * DH_C
OUT_C = H_C * 2 * DH_C

kernel_name = "hybrid_natten_conformer_diffattn_prefix_dit_step"


def _rms(x, g):
    xf = x.astype(jnp.float32)
    y = xf * lax.rsqrt(jnp.mean(xf * xf, axis=-1, keepdims=True) + EPS)
    return y.astype(x.dtype) * g


def _layernorm(x, g, b):
    xf = x.astype(jnp.float32)
    mu = jnp.mean(xf, axis=-1, keepdims=True)
    xc = xf - mu
    y = xc * lax.rsqrt(jnp.mean(xc * xc, axis=-1, keepdims=True) + EPS)
    return y.astype(x.dtype) * g + b


def _swiglu(h, w1, w3, w2):
    return (jax.nn.silu(h @ w1) * (h @ w3)) @ w2


def _adaln(x, m, i, g):
    return _rms(x, g) * (1.0 + m[:, None, 3 * i + 1]) + m[:, None, 3 * i]


def _gate(m, i):
    return m[:, None, 3 * i + 2]


def _heads(t, n_heads):
    b, n, _ = t.shape
    return t.reshape(b, n, n_heads, -1).transpose(0, 2, 1, 3)


def _merge(t):
    b, h, n, d = t.shape
    return t.transpose(0, 2, 1, 3).reshape(b, n, h * d)


def _query_blocks(fn, q):
    b, h, n, d = q.shape
    qb = q.reshape(b, h, n // QBLOCK, QBLOCK, d).transpose(2, 0, 1, 3, 4)
    out = lax.map(fn, qb)
    nb, _, ho, _, do = out.shape
    return out.transpose(1, 2, 0, 3, 4).reshape(b, ho, n, do)


def _attn_block(qb, k, v, scale):
    s = jnp.einsum('bhqd,bhkd->bhqk', qb, k).astype(jnp.float32) * scale
    p = jax.nn.softmax(s, axis=-1).astype(v.dtype)
    return jnp.einsum('bhqk,bhkd->bhqd', p, v)


def _diff_block(qb, k, v, lam, scale):
    b, h2, nq, _ = qb.shape
    s = jnp.einsum('bhqd,bhkd->bhqk', qb, k).astype(jnp.float32) * scale
    p = jax.nn.softmax(s, axis=-1).reshape(b, h2 // 2, 2, nq, -1)
    a = (p[:, :, 0] - lam * p[:, :, 1]).astype(v.dtype)
    return jnp.einsum('bhqk,bhkd->bhqd', a, v)


def _axial_rope(x):
    n, dh = x.shape[2], x.shape[3]
    t = jnp.arange(n)
    nf = dh // 4
    inv = ROPE_BASE ** (-jnp.arange(nf, dtype=jnp.float32) / nf)

    def rot(xh, pos):
        ang = pos.astype(jnp.float32)[:, None] * inv[None, :]
        cos = jnp.cos(ang).astype(x.dtype)
        sin = jnp.sin(ang).astype(x.dtype)
        x1, x2 = xh[..., :nf], xh[..., nf:]
        return jnp.concatenate([x1 * cos - x2 * sin, x2 * cos + x1 * sin], axis=-1)

    return jnp.concatenate([rot(x[..., : dh // 2], t // GRID_W), rot(x[..., dh // 2:], t % GRID_W)], axis=-1)


def _neighbourhood_attn(q, k, v, ck, cv, rpb):
    b, h, n, d = q.shape
    rows = n // GRID_W
    kh = min(WIN_H, rows)
    scale = d ** -0.5
    kg = k.reshape(b, h, rows, GRID_W, d)
    vg = v.reshape(b, h, rows, GRID_W, d)
    qg = q.reshape(b, h, rows, GRID_W, d).transpose(2, 0, 1, 3, 4)
    cols = jnp.arange(GRID_W)
    cs = jnp.clip(cols - WIN_W // 2, 0, GRID_W - WIN_W)
    col_mask = (cols[None, :] >= cs[:, None]) & (cols[None, :] < cs[:, None] + WIN_W)
    cidx = jnp.clip(cols[None, :] - cols[:, None] + WIN_W - 1, 0, 2 * WIN_W - 2)
    rpb_cols = rpb[:, :, cidx]

    def row_fn(args):
        r, qr = args
        rs = jnp.clip(r - kh // 2, 0, rows - kh)
        kb = lax.dynamic_slice_in_dim(kg, rs, kh, axis=2)
        vb = lax.dynamic_slice_in_dim(vg, rs, kh, axis=2)
        ridx = rs + jnp.arange(kh) - r + WIN_H - 1
        bias = rpb_cols[:, ridx].transpose(0, 2, 1, 3).astype(jnp.float32)
        s_lat = jnp.einsum('bhcd,bhjed->bhcje', qr, kb).astype(jnp.float32) * scale + bias[None]
        s_lat = jnp.where(col_mask[:, None, :], s_lat, -jnp.inf)
        s_ctx = jnp.einsum('bhcd,bhkd->bhck', qr, ck).astype(jnp.float32) * scale
        nc = s_ctx.shape[-1]
        s = jnp.concatenate([s_ctx, s_lat.reshape(b, h, GRID_W, kh * GRID_W)], axis=-1)
        p = jax.nn.softmax(s, axis=-1).astype(v.dtype)
        o_ctx = jnp.einsum('bhck,bhkd->bhcd', p[..., :nc], cv)
        o_lat = jnp.einsum('bhcje,bhjed->bhcd', p[..., nc:].reshape(b, h, GRID_W, kh, GRID_W), vb)
        return o_ctx + o_lat

    out = lax.map(row_fn, (jnp.arange(rows), qg))
    return out.transpose(1, 2, 0, 3, 4).reshape(b, h, n, d)


def _conv_module(u, dw_w, dw_b, ln_g, ln_b):
    a, gt = jnp.split(u, 2, axis=-1)
    z = a * jax.nn.sigmoid(gt)
    z = lax.conv_general_dilated(z, dw_w[:, None, :], window_strides=(1,),
                                 padding=((CONV_W // 2, CONV_W // 2),),
                                 dimension_numbers=('NWC', 'WIO', 'NWC'),
                                 feature_group_count=C_B) + dw_b
    return jax.nn.silu(_layernorm(z, ln_g, ln_b))


def _even_project(h, w_in):
    u = h @ w_in
    qa, ka, va, ub = jnp.split(u, [W_A, 2 * W_A, 3 * W_A], axis=-1)
    return _heads(qa, H_A), _heads(ka, H_A), _heads(va, H_A), ub


def _odd_project(h, w_in):
    u = h @ w_in
    q, k, v = jnp.split(u, [2 * H_C * DH_C, 4 * H_C * DH_C], axis=-1)
    return _heads(q, 2 * H_C), _heads(k, 2 * H_C), _heads(v, H_C)


def _diff_lambda(lp, lam_init):
    lf = lp.astype(jnp.float32)
    return jnp.exp(jnp.sum(lf[0] * lf[1])) - jnp.exp(jnp.sum(lf[2] * lf[3])) + lam_init


def _diff_out(o, subln_g, lam_init, w_out):
    return _merge(_rms(o, subln_g) * (1.0 - lam_init)) @ w_out


def setup_inputs(seed: int = 0) -> dict:
    key = jax.random.key(seed)
    ks = jax.random.split(key, 32)
    f32 = jnp.float32
    nrm = lambda k, shape, s: jax.random.normal(k, shape, f32) * s
    return {
        'x_prompt': nrm(ks[0], (BATCH, SEQ, D_MODEL), 1.0),
        'x_sample': nrm(ks[1], (DEC_BATCH, DEC_SEQ, D_MODEL), 1.0),
        'c': nrm(ks[2], (DEC_BATCH, D_MODEL), 1.0),
        'cache_a_k': nrm(ks[3], (DEC_BATCH, N_EVEN, H_A, PAST_LEN, DH_A), 1.0),
        'cache_a_v': nrm(ks[4], (DEC_BATCH, N_EVEN, H_A, PAST_LEN, DH_A), 1.0),
        'cache_c_k': nrm(ks[5], (DEC_BATCH, N_ODD, 2 * H_C, PAST_LEN, DH_C), 1.0),
        'cache_c_v': nrm(ks[6], (DEC_BATCH, N_ODD, H_C, PAST_LEN, 2 * DH_C), 1.0),
        'c_ctx': nrm(ks[7], (D_MODEL,), 1.0),
        'w_mod': nrm(ks[8], (DEPTH, D_MODEL, N_MOD * D_MODEL), 0.5 * D_MODEL ** -0.5),
        'b_mod': nrm(ks[9], (DEPTH, N_MOD * D_MODEL), 0.02),
        'norm_g': 1.0 + nrm(ks[10], (DEPTH, N_SUB, D_MODEL), 0.02),
        'ffn_w1': nrm(ks[11], (DEPTH, 2, D_MODEL, D_FF), D_MODEL ** -0.5),
        'ffn_w3': nrm(ks[12], (DEPTH, 2, D_MODEL, D_FF), D_MODEL ** -0.5),
        'ffn_w2': nrm(ks[13], (DEPTH, 2, D_FF, D_MODEL), D_FF ** -0.5),
        'a_w_in': nrm(ks[14], (N_EVEN, D_MODEL, IN_A), D_MODEL ** -0.5),
        'a_w_out': nrm(ks[15], (N_EVEN, OUT_A, D_MODEL), OUT_A ** -0.5),
        'a_rpb': nrm(ks[16], (N_EVEN, H_A, 2 * WIN_H - 1, 2 * WIN_W - 1), 0.1),
        'b_dw_w': nrm(ks[17], (N_EVEN, CONV_W, C_B), CONV_W ** -0.5),
        'b_dw_b': nrm(ks[18], (N_EVEN, C_B), 0.02),
        'b_ln_g': 1.0 + nrm(ks[19], (N_EVEN, C_B), 0.02),
        'b_ln_b': nrm(ks[20], (N_EVEN, C_B), 0.02),
        'c_w_in': nrm(ks[21], (N_ODD, D_MODEL, IN_C), D_MODEL ** -0.5),
        'c_w_out': nrm(ks[22], (N_ODD, OUT_C, D_MODEL), OUT_C ** -0.5),
        'c_lambda': nrm(ks[23], (N_ODD, 4, DH_C), 0.1),
        'c_subln_g': 1.0 + nrm(ks[24], (N_ODD, 2 * DH_C), 0.02),
        'final_g': 1.0 + nrm(ks[25], (D_MODEL,), 0.02),
    }


def reference(x_prompt, x_sample, c, cache_a_k, cache_a_v, cache_c_k, cache_c_v, c_ctx,
              w_mod, b_mod, norm_g, ffn_w1, ffn_w3, ffn_w2,
              a_w_in, a_w_out, a_rpb, b_dw_w, b_dw_b, b_ln_g, b_ln_b,
              c_w_in, c_w_out, c_lambda, c_subln_g, final_g):
    xp = x_prompt
    xs = x_sample
    new_a_k, new_a_v, new_c_k, new_c_v = [], [], [], []
    for l in range(DEPTH):
        m_ctx = (jax.nn.silu(c_ctx) @ w_mod[l] + b_mod[l]).reshape(1, N_MOD, D_MODEL)
        m_lat = (jax.nn.silu(c) @ w_mod[l] + b_mod[l]).reshape(-1, N_MOD, D_MODEL)
        g = norm_g[l]
        xp = xp + 0.5 * _gate(m_ctx, 0) * _swiglu(_adaln(xp, m_ctx, 0, g[0]), ffn_w1[l, 0], ffn_w3[l, 0], ffn_w2[l, 0])
        xs = xs + 0.5 * _gate(m_lat, 0) * _swiglu(_adaln(xs, m_lat, 0, g[0]), ffn_w1[l, 0], ffn_w3[l, 0], ffn_w2[l, 0])
        hp = _adaln(xp, m_ctx, 1, g[1])
        hs = _adaln(xs, m_lat, 1, g[1])
        if l % 2 == 0:
            e = l // 2
            conv_p = (b_dw_w[e], b_dw_b[e], b_ln_g[e], b_ln_b[e])
            q, k, v, ub = _even_project(hp, a_w_in[e])
            o_a = _query_blocks(lambda qb: _attn_block(qb, k, v, DH_A ** -0.5), q)
            yp = jnp.concatenate([_merge(o_a), _conv_module(ub, *conv_p)], axis=-1) @ a_w_out[e]
            new_a_k.append(k)
            new_a_v.append(v)
            q, k, v, ub = _even_project(hs, a_w_in[e])
            o_a = _neighbourhood_attn(q, k, v, cache_a_k[:, e], cache_a_v[:, e], a_rpb[e])
            ys = jnp.concatenate([_merge(o_a), _conv_module(ub, *conv_p)], axis=-1) @ a_w_out[e]
        else:
            o = l // 2
            lam_init = 0.8 - 0.6 * math.exp(-0.3 * l)
            lam = _diff_lambda(c_lambda[o], lam_init)
            sc = DH_C ** -0.5
            q, k, v = _odd_project(hp, c_w_in[o])
            op = _query_blocks(lambda qb: _diff_block(qb, k, v, lam, sc), q)
            yp = _diff_out(op, c_subln_g[o], lam_init, c_w_out[o])
            new_c_k.append(k)
            new_c_v.append(v)
            q, k, v = _odd_project(hs, c_w_in[o])
            q = _axial_rope(q)
            k_all = jnp.concatenate([cache_c_k[:, o], _axial_rope(k)], axis=2)
            v_all = jnp.concatenate([cache_c_v[:, o], v], axis=2)
            os_ = _query_blocks(lambda qb: _diff_block(qb, k_all, v_all, lam, sc), q)
            ys = _diff_out(os_, c_subln_g[o], lam_init, c_w_out[o])
        xp = xp + _gate(m_ctx, 1) * yp
        xs = xs + _gate(m_lat, 1) * ys
        xp = xp + 0.5 * _gate(m_ctx, 2) * _swiglu(_adaln(xp, m_ctx, 2, g[2]), ffn_w1[l, 1], ffn_w3[l, 1], ffn_w2[l, 1])
        xs = xs + 0.5 * _gate(m_lat, 2) * _swiglu(_adaln(xs, m_lat, 2, g[2]), ffn_w1[l, 1], ffn_w3[l, 1], ffn_w2[l, 1])
    y_prompt = _rms(xp, final_g)
    y_sample = _rms(xs, final_g)
    out_a_k = jnp.stack(new_a_k, axis=1)
    out_a_v = jnp.stack(new_a_v, axis=1)
    out_c_k = jnp.stack(new_c_k, axis=1)
    out_c_v = jnp.stack(new_c_v, axis=1)
    return (y_prompt, y_sample, out_a_k, out_a_v, out_c_k, out_c_v)
```

```cpp
#include <hip/hip_runtime.h>
#include <cstdio>
#include <cstdint>

#ifndef MK_SPLIT
#define MK_SPLIT 0
#endif

#define LAS __attribute__((address_space(3)))
__device__ __forceinline__ int opq_s(int x) { asm volatile("" : "+s"(x)); return x; }
__device__ __forceinline__ int opq_v(int x) { asm volatile("" : "+v"(x)); return x; }
extern __shared__ __attribute__((aligned(16))) unsigned char mk_lds[];
constexpr int WTAB_OFF = 135168 + 256;
__device__ __forceinline__ int mk_tidx() {
    const unsigned slot = (unsigned)__builtin_amdgcn_s_getreg(((6 - 1) << 11) | 4) & 63u;
    const int w = __builtin_amdgcn_readfirstlane(((const LAS int*)(mk_lds + WTAB_OFF))[slot]);
    const int lane = (int)__builtin_amdgcn_mbcnt_hi(~0u, __builtin_amdgcn_mbcnt_lo(~0u, 0u));
    return opq_v(w * 64 + lane);
}
#define TIDX() mk_tidx()
template <int K> __device__ __forceinline__ float swz_xor(float v) { return __int_as_float(__builtin_amdgcn_ds_swizzle(__float_as_int(v), (K << 10) | 0x1f)); }
typedef unsigned short bf16_t;
typedef short bf16x8 __attribute__((ext_vector_type(8)));
typedef short s16x4 __attribute__((ext_vector_type(4)));
typedef float f32x4 __attribute__((ext_vector_type(4)));
typedef float f32x2 __attribute__((ext_vector_type(2)));
typedef float f32x16 __attribute__((ext_vector_type(16)));
typedef unsigned u32x4 __attribute__((ext_vector_type(4)));
typedef unsigned u32x2 __attribute__((ext_vector_type(2)));

constexpr int DM = 2048, NCTX = 4096, NLAT = 16384, MTOK = NCTX + NLAT, DFF = 5632, NMOD = 9;
constexpr int INA = 5120, INC = 6144;
constexpr float EPS = 1e-6f;
constexpr float LAM_INIT = 0.35550906759096926f;
constexpr float QSC = 0.12751743074602467f;

constexpr size_t MiB = (size_t)1 << 20;
constexpr size_t WS_CTL = 0, CTL_BYTES = 64 * 1024;
constexpr size_t WS_MOD = 1 * MiB;
constexpr size_t WS_ROPE = 2 * MiB;
constexpr size_t WS_CAK = 3 * MiB, WS_CAV = 7 * MiB, WS_CCK = 11 * MiB, WS_CCV = 19 * MiB;
constexpr size_t WS_W13 = 32 * MiB, W13_BYTES = 44 * MiB;
constexpr size_t WS_W2 = 208 * MiB, W2_BYTES = 22 * MiB;
constexpr size_t WS_WINA = 296 * MiB, WS_WINC = 316 * MiB, WS_WOA = 340 * MiB, WS_WOC = 348 * MiB;
constexpr int XS = 2176;
constexpr size_t WS_X = 356 * MiB;
constexpr size_t WS_H = 522 * MiB;
constexpr size_t WS_U = 676 * MiB;
constexpr size_t WS_AO = 916 * MiB;
constexpr size_t WS_END = 996 * MiB;
constexpr int CW_BAR = 1024;

constexpr size_t OUT_Y = 0, OUT_AK = (size_t)MTOK * DM, OUT_AV = OUT_AK + 4194304, OUT_CK = OUT_AV + 4194304, OUT_CV = OUT_CK + 8388608;

constexpr int LDS_BYTES = 147456;
constexpr int MISC_OFF = 135168;

namespace pg8 {
constexpr int BM = 256, BK = 64, HALF = 128, HTB = HALF * BK * 2, STAGE_BYTES = 8 * HTB, NXCD = 8, WGM = 4;
#ifndef WGM_UP
#define WGM_UP 8
#endif
#ifndef WGM_DN
#define WGM_DN 4
#endif
__host__ __device__ __forceinline__ int lds_byte(int r, int c) { const int st = (r >> 4) * 2 + (c >> 5), rr = r & 15, cc = c & 31, ob = rr * 64 + cc * 2; return st * 1024 + (ob ^ (((ob >> 9) & 1) << 5)); }
__host__ __device__ __forceinline__ void stage_rc(int b, int& R, int& C) { const int st = b / 1024, sb = b % 1024, swz = sb ^ (((sb >> 9) & 1) << 5); R = (st >> 1) * 16 + swz / 64; C = (st & 1) * 32 + (swz % 64) / 2; }
__host__ __device__ __forceinline__ int perm32(int rho) { const int n = rho >> 4, i = rho & 15; return 8 * (i >> 2) + 4 * n + (i & 3); }
struct Unit { int pm, pn, kt0, nkt, part; };
struct Gemm { const bf16_t* A; const bf16_t* Bt; int M, N, K; int atiled; };
struct StaticOrder {
    int nM, nN, nwg, G, c, nt, lim, wgm;
    __device__ void init(int M, int N, int K, int G_, int c_, int wgm_ = WGM) { nM = M / BM; nN = N / BM; nwg = nM * nN; G = G_; c = c_; nt = K / BK; lim = nwg; wgm = wgm_; }
    __device__ bool next(int i, Unit& u) const {
        const long L = (long)i * G + c; if (L >= lim) return false;
        int wgid = (int)L; { const int q = nwg / NXCD, r = nwg % NXCD, xcd = wgid % NXCD, off = wgid / NXCD; wgid = (xcd < r ? xcd * (q + 1) : r * (q + 1) + (xcd - r) * q) + off; }
        const int nig = wgm * nN, gid = wgid / nig, fm = gid * wgm, gsz = (nM - fm) < wgm ? (nM - fm) : wgm;
        u.pm = fm + ((wgid % nig) % gsz); u.pn = (wgid % nig) / gsz; u.kt0 = 0; u.nkt = nt; u.part = 0; return true;
    }
    __device__ __forceinline__ void a_ready(const Unit&) const {}
    __device__ __forceinline__ void done(const Unit&) const {}
};
struct HalfOrder {
    int nM, nN, nwg, G, c, nt, base, wgm;
    __device__ void init(int M, int N, int K, int G_, int c_, int base_, int wgm_ = WGM) { nM = M / BM; nN = N / BM; nwg = nM * nN; G = G_; c = c_; nt = K / BK; base = base_; wgm = wgm_; }
    __device__ bool next(int i, Unit& u) const {
        if (i > 0) return false;
        const int x = c % NXCD, y = c / NXCD, L = base + x + NXCD * (y >> 1); if (L >= nwg) return false;
        int wgid = L; { const int q = nwg / NXCD, r = nwg % NXCD, xcd = wgid % NXCD, off = wgid / NXCD; wgid = (xcd < r ? xcd * (q + 1) : r * (q + 1) + (xcd - r) * q) + off; }
        const int nig = wgm * nN, gid = wgid / nig, fm = gid * wgm, gsz = (nM - fm) < wgm ? (nM - fm) : wgm;
        u.pm = fm + ((wgid % nig) % gsz); u.pn = (wgid % nig) / gsz; u.kt0 = 0; u.nkt = nt; u.part = y & 1; return true;
    }
    __device__ __forceinline__ void a_ready(const Unit&) const {}
    __device__ __forceinline__ void done(const Unit&) const {}
};
struct DnOrder {
    int c, nt;
    __device__ void init(int K, int c_) { c = c_; nt = K / BK; }
    __device__ bool next(int i, Unit& u) const {
        if (i >= 2) return false;
        const int xcd = c % NXCD, slot = c / NXCD, grp = i * NXCD + xcd;
        u.pm = 4 * grp + (slot & 3); u.pn = slot >> 2; u.kt0 = 0; u.nkt = nt; u.part = 0; return true;
    }
    __device__ __forceinline__ void a_ready(const Unit&) const {}
    __device__ __forceinline__ void done(const Unit&) const {}
};
struct DnHalfOrder {
    int c, nt;
    __device__ void init(int K, int c_) { c = c_; nt = K / BK; }
    __device__ bool next(int i, Unit& u) const {
        if (i > 0) return false;
        const int x = c % NXCD, y = c / NXCD, grp = 16 + (x >> 1), w = (x & 1) * 16 + (y >> 1);
        u.pm = 4 * grp + (w & 3); u.pn = w >> 2; u.kt0 = 0; u.nkt = nt; u.part = y & 1; return true;
    }
    __device__ __forceinline__ void a_ready(const Unit&) const {}
    __device__ __forceinline__ void done(const Unit&) const {}
};
__device__ __forceinline__ unsigned cvt_pk_bf16(float lo, float hi) { unsigned r; asm volatile("v_cvt_pk_bf16_f32 %0, %1, %2" : "=v"(r) : "v"(lo), "v"(hi)); return r; }

template <class Epi, class Sched, bool ALIGN_EPI = false, bool SP2 = false, int NB = 2>
__device__ __forceinline__ void gemm_phase(LAS unsigned char* lds, const Gemm g, const Sched& S, const Epi& E) {
    const int tid = TIDX(), wid = __builtin_amdgcn_readfirstlane(tid >> 6), lane = tid & 63, wr = wid >> 2, wc = wid & 3, fr = lane & 15, fq = lane >> 4;
    const int K = g.K;
    unsigned voffA[2], voffB[2];
#pragma unroll
    for (int i = 0; i < 2; ++i) { int R, C; stage_rc(tid * 16 + i * 8192, R, C); const int Rb = Epi::PERM ? ((R & ~31) + perm32(R & 31)) : R;
        voffA[i] = g.atiled ? (unsigned)(tid * 16 + i * 8192) : (unsigned)(R * K + C) * 2u; (void)Rb; voffB[i] = (unsigned)(tid * 16 + i * 8192); }
    const size_t kstep = g.atiled ? (size_t)(2 * HTB) : (size_t)(BK * 2);
    const size_t hstep = g.atiled ? (size_t)HTB : (size_t)HALF * K * 2;
    const size_t tstep = g.atiled ? (size_t)(K / BK) * (size_t)(2 * HTB) : 2 * (size_t)HALF * K * 2;
    const size_t kstepB = (size_t)(2 * HTB), hstepB = (size_t)HTB, tstepB = (size_t)(K / BK) * kstepB;
    const size_t bh = (NB == 2) ? hstepB : 0;
    static_assert(SP2, "the tiled B image is wired into the SP2 schedule only");
    const unsigned ldsw = (unsigned)wid * 1024u;
    const int aoff = lds_byte(wr * 64 + fr, fq * 8), boff = lds_byte(wc * 32 + fr, fq * 8);
#define PG8_SA(b, h) (((b) * 2 + (h)) * HTB)
#define PG8_SB(b, h) ((4 + (b) * 2 + (h)) * HTB)
#define PG8_STAGE(bufoff, gbase, voff) do { _Pragma("unroll") for (int _i = 0; _i < 2; ++_i) \
        __builtin_amdgcn_global_load_lds((const unsigned*)((const char*)(gbase) + (voff)[_i]), (LAS unsigned*)(lds + (bufoff) + ldsw + _i * 8192), 16, 0, 0); } while (0)
#define PG8_LDA(dst, b, h) do { _Pragma("unroll") for (int m = 0; m < 4; ++m) _Pragma("unroll") for (int k = 0; k < 2; ++k) dst[m][k] = *(const LAS bf16x8*)(lds + PG8_SA(b, h) + aoff + m * 2048 + k * 1024); } while (0)
#define PG8_LDB(dst, b, h) do { _Pragma("unroll") for (int n = 0; n < 2; ++n) _Pragma("unroll") for (int k = 0; k < 2; ++k) dst[n][k] = *(const LAS bf16x8*)(lds + PG8_SB(b, h) + boff + n * 2048 + k * 1024); } while (0)
#define PG8_MMA(ai, bj, At, Bt) do { __builtin_amdgcn_s_setprio(3); _Pragma("unroll") for (int m = 0; m < 4; ++m) _Pragma("unroll") for (int n = 0; n < 2; ++n) _Pragma("unroll") for (int k = 0; k < 2; ++k) \
        acc[ai][bj][m][n] = __builtin_amdgcn_mfma_f32_16x16x32_bf16(Bt[n][k], At[m][k], acc[ai][bj][m][n], 0, 0, 0); __builtin_amdgcn_s_setprio(0); } while (0)
#define PG8_WAIT_V(n) asm volatile("s_waitcnt vmcnt(" #n ")" ::: "memory")
#define PG8_WAIT_L(n) asm volatile("s_waitcnt lgkmcnt(" #n ")" ::: "memory")
#define PG8_BAR __builtin_amdgcn_s_barrier()
#define PG8_SCHED __builtin_amdgcn_sched_barrier(0)
    Unit cur, nxt; int ui = 0;
    if (!S.next(0, cur)) return;
    f32x4 acc[2][2][4][2];
#pragma unroll
    for (int a = 0; a < 2; ++a)
#pragma unroll
        for (int b = 0; b < 2; ++b)
#pragma unroll
            for (int m = 0; m < 4; ++m)
#pragma unroll
                for (int n = 0; n < 2; ++n) acc[a][b][m][n] = (f32x4){0.f, 0.f, 0.f, 0.f};
    bf16x8 At[4][2], B0[2][2], B1[2][2];
    const char* cA = (const char*)g.A + (size_t)cur.pm * tstep + (size_t)cur.kt0 * kstep; const char* cB = (const char*)g.Bt + (size_t)cur.pn * tstepB + (NB == 1 ? (size_t)cur.part * hstepB : 0) + (size_t)cur.kt0 * kstepB;
    S.a_ready(cur);
    if constexpr (SP2) {
        PG8_STAGE(PG8_SB(0, 0), cB, voffB); PG8_STAGE(PG8_SB(0, 1), cB + bh, voffB); PG8_STAGE(PG8_SA(0, 0), cA, voffA); PG8_STAGE(PG8_SA(0, 1), cA + hstep, voffA);
        if (wr == 1) PG8_BAR;
        PG8_WAIT_V(2); PG8_BAR;
        PG8_STAGE(PG8_SB(1, 0), cB + kstepB, voffB); PG8_STAGE(PG8_SA(1, 0), cA + kstep, voffA); PG8_STAGE(PG8_SB(1, 1), cB + bh + kstepB, voffB);
        PG8_WAIT_V(6); PG8_BAR;
    } else {
        PG8_STAGE(PG8_SB(0, 0), cB, voffB); PG8_STAGE(PG8_SA(0, 0), cA, voffA); PG8_STAGE(PG8_SB(0, 1), cB + hstep, voffB); PG8_STAGE(PG8_SA(0, 1), cA + hstep, voffA);
        if (wr == 1) PG8_BAR;
        PG8_WAIT_V(4); PG8_BAR;
        PG8_STAGE(PG8_SB(1, 0), cB + kstep, voffB); PG8_STAGE(PG8_SA(1, 0), cA + kstep, voffA); PG8_STAGE(PG8_SB(1, 1), cB + hstep + kstep, voffB);
        PG8_WAIT_V(6); PG8_BAR;
    }
    for (;;) {
        const bool has_next = S.next(ui + 1, nxt);
        const char* nA = has_next ? (const char*)g.A + (size_t)nxt.pm * tstep + (size_t)nxt.kt0 * kstep : cA; const char* nB = has_next ? (const char*)g.Bt + (size_t)nxt.pn * tstepB + (NB == 1 ? (size_t)nxt.part * hstepB : 0) + (size_t)nxt.kt0 * kstepB : cB;
        const int nt = cur.nkt;
        for (int t = 0; t < nt; t += 2) {
            const bool last = (t == nt - 2);
            const char* a1 = cA + (size_t)(t + 1) * kstep;
            const char* a2 = last ? nA : cA + (size_t)(t + 2) * kstep; const char* b2 = last ? nB : cB + (size_t)(t + 2) * kstepB;
            const char* a3 = a2 + kstep; const char* b3 = b2 + kstepB;
            if (last && has_next) S.a_ready(nxt);
            if constexpr (SP2) {
            PG8_LDB(B0, 0, 0); if constexpr (NB == 2) PG8_LDB(B1, 0, 1); PG8_SCHED; PG8_LDA(At, 0, 0); PG8_STAGE(PG8_SA(1, 1), a1 + hstep, voffA);
            PG8_WAIT_V(8); PG8_WAIT_L(0); PG8_BAR; PG8_MMA(0, 0, At, B0); if constexpr (NB == 2) PG8_MMA(0, 1, At, B1); PG8_BAR; PG8_SCHED;
            PG8_LDA(At, 0, 1); PG8_STAGE(PG8_SB(0, 0), b2, voffB); PG8_STAGE(PG8_SB(0, 1), b2 + bh, voffB); PG8_STAGE(PG8_SA(0, 0), a2, voffA);
            PG8_WAIT_V(8); PG8_WAIT_L(0); PG8_BAR; PG8_MMA(1, 0, At, B0); if constexpr (NB == 2) PG8_MMA(1, 1, At, B1); PG8_BAR; PG8_SCHED;
            PG8_LDB(B0, 1, 0); if constexpr (NB == 2) PG8_LDB(B1, 1, 1); PG8_SCHED; PG8_LDA(At, 1, 0); PG8_STAGE(PG8_SA(0, 1), a2 + hstep, voffA);
            PG8_WAIT_V(8); PG8_WAIT_L(0); PG8_BAR; PG8_MMA(0, 0, At, B0); if constexpr (NB == 2) PG8_MMA(0, 1, At, B1); PG8_BAR; PG8_SCHED;
            PG8_LDA(At, 1, 1); PG8_STAGE(PG8_SB(1, 0), b3, voffB); PG8_STAGE(PG8_SB(1, 1), b3 + bh, voffB); PG8_STAGE(PG8_SA(1, 0), a3, voffA);
            PG8_WAIT_V(8); PG8_WAIT_L(0); PG8_BAR; PG8_MMA(1, 0, At, B0); if constexpr (NB == 2) PG8_MMA(1, 1, At, B1); PG8_BAR; PG8_SCHED;
            } else {
            PG8_LDB(B0, 0, 0); PG8_SCHED; PG8_LDA(At, 0, 0); PG8_STAGE(PG8_SA(1, 1), a1 + hstep, voffA);
            PG8_WAIT_L(8); PG8_BAR; PG8_WAIT_L(0); PG8_MMA(0, 0, At, B0); PG8_BAR; PG8_SCHED;
            PG8_LDB(B1, 0, 1); PG8_STAGE(PG8_SB(0, 0), b2, voffB);
            PG8_BAR; PG8_WAIT_L(0); PG8_MMA(0, 1, At, B1); PG8_BAR;
            PG8_LDA(At, 0, 1); PG8_STAGE(PG8_SA(0, 0), a2, voffA);
            PG8_BAR; PG8_WAIT_L(0); PG8_MMA(1, 0, At, B0); PG8_BAR; PG8_SCHED;
            PG8_STAGE(PG8_SB(0, 1), b2 + hstep, voffB);
            PG8_WAIT_V(6); PG8_BAR; PG8_MMA(1, 1, At, B1); PG8_BAR;
            PG8_LDB(B0, 1, 0); PG8_SCHED; PG8_LDA(At, 1, 0); PG8_STAGE(PG8_SA(0, 1), a2 + hstep, voffA);
            PG8_WAIT_L(8); PG8_BAR; PG8_WAIT_L(0); PG8_MMA(0, 0, At, B0); PG8_BAR; PG8_SCHED;
            PG8_LDB(B1, 1, 1); PG8_STAGE(PG8_SB(1, 0), b3, voffB);
            PG8_BAR; PG8_WAIT_L(0); PG8_MMA(0, 1, At, B1); PG8_BAR;
            PG8_LDA(At, 1, 1); PG8_STAGE(PG8_SA(1, 0), a3, voffA);
            PG8_BAR; PG8_WAIT_L(0); PG8_MMA(1, 0, At, B0); PG8_BAR; PG8_SCHED;
            PG8_STAGE(PG8_SB(1, 1), b3 + hstep, voffB);
            PG8_WAIT_V(6); PG8_BAR; PG8_MMA(1, 1, At, B1); PG8_BAR;
            }
        }
        if constexpr (ALIGN_EPI) { if (wr == 0) PG8_BAR; }
        E(acc, cur, wr, wc, fr, fq); S.done(cur);
        if (!has_next) break;
#pragma unroll
        for (int a = 0; a < 2; ++a)
#pragma unroll
            for (int b = 0; b < 2; ++b)
#pragma unroll
                for (int m = 0; m < 4; ++m)
#pragma unroll
                    for (int n = 0; n < 2; ++n) acc[a][b][m][n] = (f32x4){0.f, 0.f, 0.f, 0.f};
        cur = nxt; cA = nA; cB = nB; ++ui;
        if constexpr (ALIGN_EPI) { if (wr == 1) PG8_BAR; }
    }
    PG8_WAIT_V(0);
    if constexpr (!ALIGN_EPI) { if (wr == 0) PG8_BAR; }
    PG8_BAR;
#undef PG8_SA
#undef PG8_SB
#undef PG8_STAGE
#undef PG8_LDA
#undef PG8_LDB
#undef PG8_MMA
#undef PG8_WAIT_V
#undef PG8_WAIT_L
#undef PG8_BAR
#undef PG8_SCHED
}
}

__device__ __forceinline__ float silu_mul(float a, float b) { const float e = __builtin_amdgcn_exp2f(-1.4426950408889634f * a); return a * __builtin_amdgcn_rcpf(1.0f + e) * b; }
__device__ __forceinline__ int mod_index(int pm) { return pm < 16 ? 0 : 1 + ((pm - 16) >> 4); }

__device__ __forceinline__ void unpack8(const u32x4 w, f32x4& a, f32x4& b) {
    a = (f32x4){__uint_as_float(w.x << 16), __uint_as_float(w.x & 0xffff0000u), __uint_as_float(w.y << 16), __uint_as_float(w.y & 0xffff0000u)};
    b = (f32x4){__uint_as_float(w.z << 16), __uint_as_float(w.z & 0xffff0000u), __uint_as_float(w.w << 16), __uint_as_float(w.w & 0xffff0000u)};
}
__device__ __forceinline__ u32x4 pack8(const f32x4 a, const f32x4 b) {
    u32x4 w; w.x = pg8::cvt_pk_bf16(a[0], a[1]); w.y = pg8::cvt_pk_bf16(a[2], a[3]); w.z = pg8::cvt_pk_bf16(b[0], b[1]); w.w = pg8::cvt_pk_bf16(b[2], b[3]); return w;
}
struct EpiSwiglu {
    static constexpr bool PERM = true;
    bf16_t* U;
    __device__ __forceinline__ void operator()(const f32x4 (&acc)[2][2][4][2], const pg8::Unit& u, int wr, int wc, int fr_, int fq_) const {
        const int fr = opq_v(fr_), fq = opq_v(fq_);
        const int row0 = u.pm * 256 + wr * 64 + fr, col0 = u.pn * 128 + wc * 32 + 8 * fq;
#pragma unroll
        for (int ai = 0; ai < 2; ++ai)
#pragma unroll
            for (int m = 0; m < 4; ++m) {
                bf16_t* rowp = (bf16_t*)((char*)U + (((size_t)u.pm * (DFF / 64) + (u.pn * 2 + (wc >> 1))) * 2 + ai) * 16384 + pg8::lds_byte(wr * 64 + m * 16 + fr, (wc & 1) * 32 + 8 * fq));
                const f32x4 a0 = acc[ai][0][m][0], a1 = acc[ai][0][m][1], b0 = acc[ai][1][m][0], b1 = acc[ai][1][m][1];
                u32x4 w;
                w.x = pg8::cvt_pk_bf16(silu_mul(a0[0], b0[0]), silu_mul(a0[1], b0[1])); w.y = pg8::cvt_pk_bf16(silu_mul(a0[2], b0[2]), silu_mul(a0[3], b0[3]));
                w.z = pg8::cvt_pk_bf16(silu_mul(a1[0], b1[0]), silu_mul(a1[1], b1[1])); w.w = pg8::cvt_pk_bf16(silu_mul(a1[2], b1[2]), silu_mul(a1[3], b1[3]));
                *(u32x4*)rowp = w;
            }
    }
};
template <int NB> struct EpiResidT {
    static constexpr bool PERM = true;
    const float* xp; const float* xs; bf16_t* X; const float* gate; float coef; int first;
    __device__ __forceinline__ void operator()(const f32x4 (&acc)[2][2][4][2], const pg8::Unit& u, int wr, int wc, int fr_, int fq_) const {
        const int fr = opq_v(fr_), fq = opq_v(fq_);
        const int row0 = wr * 64 + fr, col0 = u.pn * 256 + (NB == 1 ? u.part * 128 : 0) + wc * 32 + 8 * fq;
        const float* basef = u.pm < 16 ? xp + (size_t)u.pm * 256 * DM : xs + (size_t)(u.pm - 16) * 256 * DM;
        bf16_t* xb = X + (size_t)u.pm * 256 * XS;
        const float* g = gate + (size_t)mod_index(u.pm) * NMOD * DM + col0;
        f32x4 gv[NB][2];
#pragma unroll
        for (int bj = 0; bj < NB; ++bj)
#pragma unroll
            for (int n = 0; n < 2; ++n) gv[bj][n] = *(const f32x4*)(g + bj * 128 + n * 4) * coef;
#pragma unroll
        for (int ai = 0; ai < 2; ++ai)
#pragma unroll
            for (int m = 0; m < 4; ++m) { const int r = row0 + ai * 128 + m * 16;
#pragma unroll
                for (int bj = 0; bj < NB; ++bj) { f32x4 b0, b1;
                    if (first) { const float* bp = basef + (size_t)r * DM + col0 + bj * 128; b0 = *(const f32x4*)bp; b1 = *(const f32x4*)(bp + 4); }
                    else unpack8(*(const u32x4*)(xb + (size_t)r * XS + col0 + bj * 128), b0, b1);
                    *(u32x4*)(xb + (size_t)r * XS + col0 + bj * 128) = pack8(b0 + gv[bj][0] * acc[ai][bj][m][0], b1 + gv[bj][1] * acc[ai][bj][m][1]); } }
    }
};
using EpiResid = EpiResidT<2>;
template <int NB> struct EpiQkvEvenT {
    static constexpr bool PERM = true;
    bf16_t* QKV; float* out_k; float* out_v;
    __device__ __forceinline__ void operator()(const f32x4 (&acc)[2][2][4][2], const pg8::Unit& u, int wr, int wc, int fr_, int fq_) const {
        const int fr = opq_v(fr_), fq = opq_v(fq_);
        const int rowt = wr * 64 + fr, colt = (NB == 1 ? u.part * 128 : 0) + wc * 32 + 8 * fq;
        const bool ctx = u.pm < 16; const int seg = u.pn >> 2;
        float* of = (seg == 1) ? out_k : out_v; const bool wf = ctx && (seg == 1 || seg == 2); const float qs = (seg == 0) ? QSC : 1.0f;
#pragma unroll
        for (int ai = 0; ai < 2; ++ai)
#pragma unroll
            for (int m = 0; m < 4; ++m) { const int r = rowt + ai * 128 + m * 16;
                bf16_t* rowp = QKV + (size_t)(u.pm * 256 + r) * INA + u.pn * 256 + colt;
#pragma unroll
                for (int bj = 0; bj < NB; ++bj) { const f32x4 v0 = acc[ai][bj][m][0], v1 = acc[ai][bj][m][1]; const f32x4 s0 = v0 * qs, s1 = v1 * qs;
                    u32x4 w; w.x = pg8::cvt_pk_bf16(s0[0], s0[1]); w.y = pg8::cvt_pk_bf16(s0[2], s0[3]); w.z = pg8::cvt_pk_bf16(s1[0], s1[1]); w.w = pg8::cvt_pk_bf16(s1[2], s1[3]);
                    *(u32x4*)(rowp + bj * 128) = w;
                    if (wf) { const int h = (u.pn & 3) * 2 + bj + (NB == 1 ? u.part : 0);
                        float* op = of + ((size_t)(u.pm * 8 + h) * 256 + r) * 128 + wc * 32 + 8 * fq; *(f32x4*)op = v0; *(f32x4*)(op + 4) = v1; } } }
    }
};
using EpiQkvEven = EpiQkvEvenT<2>;
struct EpiQkvOdd {
    static constexpr bool PERM = true;
    bf16_t* QKV; float* out_k; float* out_v; const float* rcos; const float* rsin;
    __device__ __forceinline__ void operator()(const f32x4 (&acc)[2][2][4][2], const pg8::Unit& u, int wr, int wc, int fr_, int fq_) const {
        const int fr = opq_v(fr_), fq = opq_v(fq_);
        const int rowt = wr * 64 + fr; const bool ctx = u.pm < 16;
        if (u.pn < 16) {
            const int isk = u.pn >> 3, head = 2 * (u.pn & 7) + (wc >> 1), part = wc & 1, i0 = 8 * fq;
            const int colb = isk * 2048 + head * 128 + part * 64 + i0;
#pragma unroll
            for (int ai = 0; ai < 2; ++ai)
#pragma unroll
                for (int m = 0; m < 4; ++m) { const int r = rowt + ai * 128 + m * 16;
                    f32x4 x1a = acc[ai][0][m][0], x1b = acc[ai][0][m][1], x2a = acc[ai][1][m][0], x2b = acc[ai][1][m][1];
                    if (!ctx) { const int t = ((u.pm - 16) & 15) * 256 + r; const int pos = part ? (t & 63) : (t >> 6);
                        const f32x4 ca = *(const f32x4*)(rcos + pos * 32 + i0), cb = *(const f32x4*)(rcos + pos * 32 + i0 + 4), sa = *(const f32x4*)(rsin + pos * 32 + i0), sb = *(const f32x4*)(rsin + pos * 32 + i0 + 4);
                        const f32x4 o1a = x1a * ca - x2a * sa, o1b = x1b * cb - x2b * sb, o2a = x2a * ca + x1a * sa, o2b = x2b * cb + x1b * sb;
                        x1a = o1a; x1b = o1b; x2a = o2a; x2b = o2b; }
                    if (!isk) { x1a *= QSC; x1b *= QSC; x2a *= QSC; x2b *= QSC; }
                    bf16_t* rowp = QKV + (size_t)(u.pm * 256 + r) * INC + colb;
                    u32x4 w; w.x = pg8::cvt_pk_bf16(x1a[0], x1a[1]); w.y = pg8::cvt_pk_bf16(x1a[2], x1a[3]); w.z = pg8::cvt_pk_bf16(x1b[0], x1b[1]); w.w = pg8::cvt_pk_bf16(x1b[2], x1b[3]);
                    *(u32x4*)rowp = w;
                    w.x = pg8::cvt_pk_bf16(x2a[0], x2a[1]); w.y = pg8::cvt_pk_bf16(x2a[2], x2a[3]); w.z = pg8::cvt_pk_bf16(x2b[0], x2b[1]); w.w = pg8::cvt_pk_bf16(x2b[2], x2b[3]);
                    *(u32x4*)(rowp + 32) = w;
                    if (ctx && isk) { float* op = out_k + ((size_t)(u.pm * 16 + head) * 256 + r) * 128 + part * 64 + i0;
                        *(f32x4*)op = x1a; *(f32x4*)(op + 4) = x1b; *(f32x4*)(op + 32) = x2a; *(f32x4*)(op + 36) = x2b; }
                }
        } else {
            const int colt = wc * 32 + 8 * fq, h = u.pn - 16;
#pragma unroll
            for (int ai = 0; ai < 2; ++ai)
#pragma unroll
                for (int m = 0; m < 4; ++m) { const int r = rowt + ai * 128 + m * 16;
                    bf16_t* rowp = QKV + (size_t)(u.pm * 256 + r) * INC + u.pn * 256 + colt;
#pragma unroll
                    for (int bj = 0; bj < 2; ++bj) { const f32x4 v0 = acc[ai][bj][m][0], v1 = acc[ai][bj][m][1];
                        u32x4 w; w.x = pg8::cvt_pk_bf16(v0[0], v0[1]); w.y = pg8::cvt_pk_bf16(v0[2], v0[3]); w.z = pg8::cvt_pk_bf16(v1[0], v1[1]); w.w = pg8::cvt_pk_bf16(v1[2], v1[3]);
                        *(u32x4*)(rowp + bj * 128) = w;
                        if (ctx) { float* op = out_v + ((size_t)(u.pm * 8 + h) * 256 + r) * 256 + bj * 128 + colt; *(f32x4*)op = v0; *(f32x4*)(op + 4) = v1; } } }
        }
    }
};

namespace att {
constexpr int SHM_V = 64 * 128 * 2, SHM_K = 64 * 128 * 2;
constexpr float THRL = 11.541560327111707f, NEG = -1e30f;
constexpr int LDS_WS = 2 * SHM_V + 2 * SHM_K, LDS_TB = LDS_WS + 8 * 64 * 4;
#define KSWZ(row, colB) ((row) * 256 + ((colB) ^ (((row) & 7) << 4)))
#define SBAR() __builtin_amdgcn_sched_barrier(0)
__device__ __forceinline__ int crow(int r, int hi) { return (r & 3) + 8 * (r >> 2) + 4 * hi; }
__device__ __forceinline__ unsigned cvtpk(float lo, float hi) { unsigned r; asm volatile("v_cvt_pk_bf16_f32 %0, %1, %2" : "=v"(r) : "v"(lo), "v"(hi)); return r; }
__device__ __forceinline__ void partialSM(f32x16& p0, f32x16& p1, float& m_reg, float& mn, float& alpha, float l_reg) {
  float pmax = p0[0];
#pragma unroll
  for (int r = 1; r < 16; ++r) pmax = fmaxf(pmax, p0[r]);
#pragma unroll
  for (int r = 0; r < 16; ++r) pmax = fmaxf(pmax, p1[r]);
  { auto rr = __builtin_amdgcn_permlane32_swap(__float_as_uint(pmax), __float_as_uint(pmax), false, false);
    pmax = fmaxf(__uint_as_float(rr[0]), __uint_as_float(rr[1])); }
  const float dm = pmax - m_reg;
  if (__builtin_expect(__all(dm <= THRL && !(l_reg == 0.f && dm < -THRL)), 1)) { mn = m_reg; alpha = 1.f; }
  else { const bool fresh = (l_reg == 0.f); mn = fresh ? (fabsf(dm) > THRL ? pmax : m_reg) : fmaxf(m_reg, pmax); alpha = fresh ? 1.f : __builtin_amdgcn_exp2f(m_reg - mn); m_reg = mn; }
  if (!__builtin_expect(__all(mn == 0.f), 1)) {
#pragma unroll
    for (int r = 0; r < 16; ++r) { p0[r] -= mn; p1[r] -= mn; }
  }
#pragma unroll
  for (int r = 0; r < 16; ++r) p0[r] = __builtin_amdgcn_exp2f(p0[r]);
}
__device__ __forceinline__ void finishSM(f32x16& p0, f32x16& p1, float alpha, float& l_reg, bf16x8& pa0, bf16x8& pa1, bf16x8& pa2, bf16x8& pa3) {
#pragma unroll
  for (int r = 0; r < 16; ++r) p1[r] = __builtin_amdgcn_exp2f(p1[r]);
  float ps = 0;
#pragma unroll
  for (int r = 0; r < 16; ++r) ps += p0[r];
#pragma unroll
  for (int r = 0; r < 16; ++r) ps += p1[r];
  { auto rr = __builtin_amdgcn_permlane32_swap(__float_as_uint(ps), __float_as_uint(ps), false, false);
    ps = __uint_as_float(rr[0]) + __uint_as_float(rr[1]); }
  l_reg = l_reg * alpha + ps;
#define PK4(P, BASE, OUT) do { u32x4 w = {cvtpk(P[BASE + 0], P[BASE + 1]), cvtpk(P[BASE + 2], P[BASE + 3]), cvtpk(P[BASE + 4], P[BASE + 5]), cvtpk(P[BASE + 6], P[BASE + 7])}; \
    OUT = *reinterpret_cast<bf16x8*>(&w); } while (0)
  PK4(p0, 0, pa0); PK4(p0, 8, pa1); PK4(p1, 0, pa2); PK4(p1, 8, pa3);
#undef PK4
}
__device__ __forceinline__ void qkt(f32x16& p0, f32x16& p1, const LAS char* Ks, const bf16x8* qr, int r32, int hi) {
  p0 = f32x16{}; p1 = f32x16{};
#pragma unroll
  for (int d0 = 0; d0 < 8; ++d0) { const int cb = (d0 * 16 + hi * 8) * 2;
    const bf16x8 b0 = *(const LAS bf16x8*)(Ks + KSWZ(r32, cb));
    const bf16x8 b1 = *(const LAS bf16x8*)(Ks + KSWZ(32 + r32, cb));
    p0 = __builtin_amdgcn_mfma_f32_32x32x16_bf16(b0, qr[d0], p0, 0, 0, 0);
    p1 = __builtin_amdgcn_mfma_f32_32x32x16_bf16(b1, qr[d0], p1, 0, 0, 0); }
}
__device__ __forceinline__ int v_st(int k, int c) { const int kk = k;     return ((kk >> 3) * 4 + (c >> 5)) * 512 + ((kk & 7) * 32 + (c & 31)) * 2; }
__device__ __forceinline__ int v_rd_base(int lane) { return ((lane & 3) << 3) | (((lane >> 2) & 3) << 6) | (((lane >> 4) & 1) << 5) | (((lane >> 5) & 1) << 8); }
constexpr int v_rd_off(int d0, int ks, int half) { return d0 * 512 + ks * 4096 + half * 2048; }
template <int OFF> __device__ __forceinline__ s16x4 tr_read(int vb) {
  s16x4 r; asm volatile("ds_read_b64_tr_b16 %0, %1 offset:%2" : "=&v"(r) : "v"(vb), "i"(OFF) : "memory"); return r;
}
template <int D0> __device__ __forceinline__ void pv_one(f32x16& od, int vb, bf16x8 pa0, bf16x8 pa1, bf16x8 pa2, bf16x8 pa3) {
  const s16x4 l0 = tr_read<v_rd_off(D0, 0, 0)>(vb), h0 = tr_read<v_rd_off(D0, 0, 1)>(vb), l1 = tr_read<v_rd_off(D0, 1, 0)>(vb), h1 = tr_read<v_rd_off(D0, 1, 1)>(vb);
  const s16x4 l2 = tr_read<v_rd_off(D0, 2, 0)>(vb), h2 = tr_read<v_rd_off(D0, 2, 1)>(vb), l3 = tr_read<v_rd_off(D0, 3, 0)>(vb), h3 = tr_read<v_rd_off(D0, 3, 1)>(vb);
  asm volatile("s_waitcnt lgkmcnt(0)" ::: "memory"); SBAR();
#define PK(L, H) (bf16x8){L[0], L[1], L[2], L[3], H[0], H[1], H[2], H[3]}
  od = __builtin_amdgcn_mfma_f32_32x32x16_bf16(pa0, PK(l0, h0), od, 0, 0, 0);
  od = __builtin_amdgcn_mfma_f32_32x32x16_bf16(pa1, PK(l1, h1), od, 0, 0, 0);
  od = __builtin_amdgcn_mfma_f32_32x32x16_bf16(pa2, PK(l2, h2), od, 0, 0, 0);
  od = __builtin_amdgcn_mfma_f32_32x32x16_bf16(pa3, PK(l3, h3), od, 0, 0, 0);
#undef PK
}
__device__ __forceinline__ void pv_d0(f32x16* o, int vb, bf16x8 pa0, bf16x8 pa1, bf16x8 pa2, bf16x8 pa3) {
  pv_one<0>(o[0], vb, pa0, pa1, pa2, pa3); pv_one<1>(o[1], vb, pa0, pa1, pa2, pa3); pv_one<2>(o[2], vb, pa0, pa1, pa2, pa3); pv_one<3>(o[3], vb, pa0, pa1, pa2, pa3);
}
struct VHalf { s16x4 la, ha, lb, hb; };
template <int D0, int KS> __device__ __forceinline__ void pvh_load(VHalf& f, int vb) {
  f.la = tr_read<v_rd_off(D0, KS, 0)>(vb); f.ha = tr_read<v_rd_off(D0, KS, 1)>(vb); f.lb = tr_read<v_rd_off(D0, KS + 1, 0)>(vb); f.hb = tr_read<v_rd_off(D0, KS + 1, 1)>(vb);
}
__device__ __forceinline__ void pvh_mma(f32x16& od, const VHalf& f, bf16x8 pa, bf16x8 pb) {
#define PK(L, H) (bf16x8){L[0], L[1], L[2], L[3], H[0], H[1], H[2], H[3]}
  od = __builtin_amdgcn_mfma_f32_32x32x16_bf16(pa, PK(f.la, f.ha), od, 0, 0, 0);
  od = __builtin_amdgcn_mfma_f32_32x32x16_bf16(pb, PK(f.lb, f.hb), od, 0, 0, 0);
#undef PK
}
#define PV_WAIT4() do { asm volatile("s_waitcnt lgkmcnt(4)" ::: "memory"); SBAR(); } while (0)
#define PV_WAIT0() do { asm volatile("s_waitcnt lgkmcnt(0)" ::: "memory"); SBAR(); } while (0)
template <int NB> __device__ __forceinline__ void pv_pipe(f32x16* o, int vb, bf16x8 pa0, bf16x8 pa1, bf16x8 pa2, bf16x8 pa3) {
  VHalf fa, fb; const int vh = vb + 16384;
  pvh_load<0, 0>(fa, vb);
  pvh_load<0, 2>(fb, vb); PV_WAIT4(); pvh_mma(o[0], fa, pa0, pa1);
  pvh_load<1, 0>(fa, vb); PV_WAIT4(); pvh_mma(o[0], fb, pa2, pa3);
  pvh_load<1, 2>(fb, vb); PV_WAIT4(); pvh_mma(o[1], fa, pa0, pa1);
  pvh_load<2, 0>(fa, vb); PV_WAIT4(); pvh_mma(o[1], fb, pa2, pa3);
  pvh_load<2, 2>(fb, vb); PV_WAIT4(); pvh_mma(o[2], fa, pa0, pa1);
  pvh_load<3, 0>(fa, vb); PV_WAIT4(); pvh_mma(o[2], fb, pa2, pa3);
  pvh_load<3, 2>(fb, vb); PV_WAIT4(); pvh_mma(o[3], fa, pa0, pa1);
  if (NB == 8) {
    pvh_load<0, 0>(fa, vh); PV_WAIT4(); pvh_mma(o[3], fb, pa2, pa3);
    pvh_load<0, 2>(fb, vh); PV_WAIT4(); pvh_mma(o[4], fa, pa0, pa1);
    pvh_load<1, 0>(fa, vh); PV_WAIT4(); pvh_mma(o[4], fb, pa2, pa3);
    pvh_load<1, 2>(fb, vh); PV_WAIT4(); pvh_mma(o[5], fa, pa0, pa1);
    pvh_load<2, 0>(fa, vh); PV_WAIT4(); pvh_mma(o[5], fb, pa2, pa3);
    pvh_load<2, 2>(fb, vh); PV_WAIT4(); pvh_mma(o[6], fa, pa0, pa1);
    pvh_load<3, 0>(fa, vh); PV_WAIT4(); pvh_mma(o[6], fb, pa2, pa3);
    pvh_load<3, 2>(fb, vh); PV_WAIT4(); pvh_mma(o[7], fa, pa0, pa1);
    PV_WAIT0(); pvh_mma(o[7], fb, pa2, pa3);
  } else { PV_WAIT0(); pvh_mma(o[3], fb, pa2, pa3); }
}
struct KV { const bf16_t* k0; const bf16_t* v0; int ldk0, ldv0, nt0; const bf16_t* k1; const bf16_t* v1; int ldk1, ldv1, base1, max1; };
struct NaW { int qrow, rsq, c, cs, rsmin; const LAS float* tb; };
__device__ __forceinline__ void na_mask(f32x16& p0, f32x16& p1, int kr, const NaW& w, int hi) {
  const LAS float* tb = w.tb + (kr - w.qrow + 7) * 31 + 15 - w.c;
  const int lo = w.cs, hi_ = w.cs + 15;
#pragma unroll
  for (int r = 0; r < 16; ++r) { const int e = crow(r, hi); const int id = e < lo ? lo : (e > hi_ ? hi_ : e); const float b = tb[id]; p0[r] = (id == e) ? p0[r] + b : NEG; }
#pragma unroll
  for (int r = 0; r < 16; ++r) { const int e = 32 + crow(r, hi); const int id = e < lo ? lo : (e > hi_ ? hi_ : e); const float b = tb[id]; p1[r] = (id == e) ? p1[r] + b : NEG; }
}
template <int MODE, int SD>
__device__ __forceinline__ void attn_body(const bf16_t* __restrict__ Qb, int ldq, const KV kv, int NT, bf16_t* __restrict__ Ob, int ldo, LAS char* lds, const NaW naw) {
  const int tid = TIDX(), wid = tid >> 6, lane = tid & 63, r32 = lane & 31, hi = lane >> 5;
  LAS char* V_lds = lds; LAS char* K_lds = lds + 2 * SHM_V;
  LAS float* wsf = (LAS float*)(lds + LDS_WS) + wid * 64; LAS float* li_l = wsf; LAS float* al_l = wsf + 32;
  float m_reg = 0.f, l_reg = 0; f32x16 o[4] = {}; bf16x8 qr[8];
  const bf16_t* Qw = Qb + (size_t)(wid * 32 + r32) * ldq + hi * 8;
#pragma unroll
  for (int d0 = 0; d0 < 8; ++d0) qr[d0] = *(const bf16x8*)(Qw + d0 * 16);
  const int sr = tid >> 4, sc = (tid & 15) * 8, vst0 = v_st(sr, sc), vst1 = v_st(32 + sr, sc);
  const int vb0 = (int)(uintptr_t)V_lds + v_rd_base(lane);
  struct { bf16x8 vs0, vs1, ks0, ks1; } sr_[SD];
#define SLOAD(i, t) do { const int t_ = (t); const bf16_t* kp_; const bf16_t* vp_; int lk_, lv_; \
    if (t_ < kv.nt0) { lk_ = kv.ldk0; lv_ = kv.ldv0; kp_ = kv.k0 + (size_t)t_ * 64 * lk_; vp_ = kv.v0 + (size_t)t_ * 64 * lv_; } \
    else { int j_ = kv.base1 + (t_ - kv.nt0); j_ = j_ < kv.max1 ? j_ : kv.max1; lk_ = kv.ldk1; lv_ = kv.ldv1; kp_ = kv.k1 + (size_t)j_ * 64 * lk_; vp_ = kv.v1 + (size_t)j_ * 64 * lv_; } \
    sr_[i].vs0 = *(const bf16x8*)(vp_ + (size_t)sr * lv_ + sc); sr_[i].vs1 = *(const bf16x8*)(vp_ + (size_t)(32 + sr) * lv_ + sc); \
    sr_[i].ks0 = *(const bf16x8*)(kp_ + (size_t)sr * lk_ + sc); sr_[i].ks1 = *(const bf16x8*)(kp_ + (size_t)(32 + sr) * lk_ + sc); } while (0)
#define SWRITE(b, i) do { *(LAS bf16x8*)(V_lds + (b) * SHM_V + vst0) = sr_[i].vs0; *(LAS bf16x8*)(V_lds + (b) * SHM_V + vst1) = sr_[i].vs1; const int kc = sc * 2; \
    *(LAS bf16x8*)(K_lds + (b) * SHM_K + KSWZ(sr, kc)) = sr_[i].ks0; *(LAS bf16x8*)(K_lds + (b) * SHM_K + KSWZ(32 + sr, kc)) = sr_[i].ks1; } while (0)
#define SWAIT() do { if (SD == 2) asm volatile("s_waitcnt vmcnt(4)" ::: "memory"); else asm volatile("s_waitcnt vmcnt(0)" ::: "memory"); } while (0)
#define RESC(a) do { if (__any((a) < 1.f)) { if (hi == 0) al_l[r32] = (a); asm volatile("s_waitcnt lgkmcnt(0)" ::: "memory"); \
    _Pragma("unroll") for (int d = 0; d < 4; ++d) _Pragma("unroll") for (int r = 0; r < 16; ++r) o[d][r] *= al_l[crow(r, hi)]; } } while (0)
#define MASK(P0, P1, t) do { } while (0)
  f32x16 pA0, pA1, pB0, pB1; float mnA, mnB, alA, alB; bf16x8 pa0, pa1, pa2, pa3;
  constexpr int SE = 0, SO = SD - 1;
  SLOAD(SE, 0); asm volatile("s_waitcnt vmcnt(0)" ::: "memory"); SWRITE(0, SE); __syncthreads();
  qkt(pA0, pA1, K_lds, qr, r32, hi); MASK(pA0, pA1, 0); partialSM(pA0, pA1, m_reg, mnA, alA, l_reg);
  SLOAD(SO, 1); if (SD == 2) { if (2 < NT) SLOAD(SE, 2); }
  SWAIT(); SWRITE(1, SO); __syncthreads();
  for (int j = 1; j + 1 < NT; j += 2) {
    SBAR(); qkt(pB0, pB1, K_lds + SHM_K, qr, r32, hi); MASK(pB0, pB1, j);
    finishSM(pA0, pA1, alA, l_reg, pa0, pa1, pa2, pa3); SBAR();
    SLOAD(SO, j + SD); SBAR();
    pv_d0(o, vb0, pa0, pa1, pa2, pa3); partialSM(pB0, pB1, m_reg, mnB, alB, l_reg);
    __syncthreads(); SWAIT(); SWRITE(0, SE);
    RESC(alB); __syncthreads();
    SBAR(); qkt(pA0, pA1, K_lds, qr, r32, hi); MASK(pA0, pA1, j + 1);
    finishSM(pB0, pB1, alB, l_reg, pa0, pa1, pa2, pa3); SBAR();
    if (SD == 1 || j + 3 < NT) SLOAD(SE, j + 1 + SD); SBAR();
    pv_d0(o, vb0 + SHM_V, pa0, pa1, pa2, pa3); partialSM(pA0, pA1, m_reg, mnA, alA, l_reg);
    __syncthreads(); SWAIT(); SWRITE(1, SO);
    RESC(alA); __syncthreads();
  }
  SBAR(); qkt(pB0, pB1, K_lds + SHM_K, qr, r32, hi); MASK(pB0, pB1, NT - 1);
  finishSM(pA0, pA1, alA, l_reg, pa0, pa1, pa2, pa3); SBAR();
  pv_d0(o, vb0, pa0, pa1, pa2, pa3); partialSM(pB0, pB1, m_reg, mnB, alB, l_reg);
  __syncthreads(); RESC(alB);
  finishSM(pB0, pB1, alB, l_reg, pa0, pa1, pa2, pa3); SBAR();
  pv_d0(o, vb0 + SHM_V, pa0, pa1, pa2, pa3);
  if (hi == 0) li_l[r32] = l_reg; asm volatile("s_waitcnt lgkmcnt(0)" ::: "memory");
  float rli[16];
#pragma unroll
  for (int r = 0; r < 16; ++r) rli[r] = __builtin_amdgcn_rcpf(li_l[crow(r, hi)]);
  bf16_t* Ow = Ob + (size_t)(wid * 32) * ldo;
#pragma unroll
  for (int r = 0; r < 16; ++r) { const int orow = crow(r, hi);
#pragma unroll
    for (int d0 = 0; d0 < 4; ++d0) Ow[(size_t)orow * ldo + d0 * 32 + r32] = (bf16_t)(cvtpk(o[d0][r] * rli[r], 0.f) & 0xffffu); }
#undef SLOAD
#undef SWRITE
#undef SWAIT
#undef RESC
#undef MASK
}
struct DKV { const bf16_t* k0; const bf16_t* k1; const bf16_t* v; int ldk, ldv, nt; };
constexpr int DBUF = 65536, D_WS = 2 * DBUF;
__device__ __forceinline__ void diff_stage(LAS char* lds, int buf, const DKV& sg, int tile, int wid, int lane) {
  const int region = wid >> 1, w1 = wid & 1;
  LAS char* dst = lds + buf * DBUF + region * 16384 + w1 * 8192;
  if (region < 2) {
    const char* src = (const char*)((region ? sg.k1 : sg.k0) + ((size_t)tile * 64 + w1 * 32) * sg.ldk);
    const int rl = lane >> 4, cp = lane & 15;
    const unsigned ve = (unsigned)(rl * sg.ldk) * 2u + (unsigned)((cp ^ rl) * 16), vo = (unsigned)(rl * sg.ldk) * 2u + (unsigned)((cp ^ (rl + 4)) * 16);
#pragma unroll
    for (int i = 0; i < 8; ++i) { const char* p = src + (size_t)(4 * i) * sg.ldk * 2;
      __builtin_amdgcn_global_load_lds((const unsigned*)(p + ((i & 1) ? vo : ve)), (LAS unsigned*)(dst + i * 1024), 16, 0, 0); }
  } else {
    const char* src = (const char*)(sg.v + (size_t)tile * 64 * sg.ldv + (region - 2) * 128);
    const int q3 = (lane & 31) >> 2;
    const unsigned vl = (unsigned)((q3 * sg.ldv + (lane >> 5) * 32 + (lane & 3) * 8) * 2);
#pragma unroll
    for (int i = 0; i < 8; ++i) { const int ku = (w1 * 4 + (i >> 1)) * 8;
      const char* p = src + ((size_t)ku * sg.ldv + (i & 1) * 64) * 2;
      __builtin_amdgcn_global_load_lds((const unsigned*)(p + vl), (LAS unsigned*)(dst + i * 1024), 16, 0, 0); }
  }
}
__device__ __forceinline__ void attn_diff_body(const bf16_t* __restrict__ Q0, int ldq, const DKV sa, const DKV sb, bf16_t* __restrict__ Ob, int ldo, LAS char* lds, float lam, const float* __restrict__ gvec) {
  const int tid = TIDX(), wid = __builtin_amdgcn_readfirstlane(tid >> 6), lane = tid & 63, r32 = lane & 31, hi = lane >> 5;
  const int s = wid >> 2, rg = wid & 3;
  LAS float* wsf = (LAS float*)(lds + D_WS) + wid * 64; LAS float* li_l = wsf; LAS float* al_l = wsf + 32;
  float m_reg = 0.f, l_reg = 0; f32x16 o[8] = {}; bf16x8 qr[8];
  const bf16_t* Qw = Q0 + (size_t)(rg * 32 + r32) * ldq + s * 128 + hi * 8;
#pragma unroll
  for (int d0 = 0; d0 < 8; ++d0) qr[d0] = *(const bf16x8*)(Qw + d0 * 16);
  const int NT = sa.nt + sb.nt;
  const int vrd = v_rd_base(lane);
#define DSTAGE(t, buf) do { const int t_ = (t); if (t_ < sa.nt) diff_stage(lds, (buf), sa, t_, wid, lane); else diff_stage(lds, (buf), sb, t_ - sa.nt, wid, lane); } while (0)
  DSTAGE(0, 0); asm volatile("s_waitcnt vmcnt(0)" ::: "memory"); __syncthreads();
  for (int t = 0; t < NT; ++t) {
    const int b = t & 1;
    if (t + 1 < NT) DSTAGE(t + 1, b ^ 1);
    f32x16 p0, p1; float mn, al; bf16x8 pa0, pa1, pa2, pa3;
    qkt(p0, p1, lds + b * DBUF + s * 16384, qr, opq_v(r32), hi);
    partialSM(p0, p1, m_reg, mn, al, l_reg);
    if (__any(al < 1.f)) { if (hi == 0) al_l[r32] = al; asm volatile("s_waitcnt lgkmcnt(0)" ::: "memory");
#pragma unroll
      for (int d = 0; d < 8; ++d)
#pragma unroll
        for (int r = 0; r < 16; ++r) o[d][r] *= al_l[crow(r, hi)]; }
    finishSM(p0, p1, al, l_reg, pa0, pa1, pa2, pa3); SBAR();
    const int vb = (int)(uintptr_t)(lds + b * DBUF + 32768) + vrd;
    pv_pipe<8>(o, vb, pa0, pa1, pa2, pa3);
    asm volatile("s_waitcnt vmcnt(0)" ::: "memory"); __syncthreads();
  }
#undef DSTAGE
  if (hi == 0) li_l[r32] = l_reg; asm volatile("s_waitcnt lgkmcnt(0)" ::: "memory");
  { float rli[16];
#pragma unroll
    for (int r = 0; r < 16; ++r) rli[r] = __builtin_amdgcn_rcpf(li_l[crow(r, hi)]);
#pragma unroll
    for (int d = 0; d < 8; ++d)
#pragma unroll
      for (int r = 0; r < 16; ++r) o[d][r] *= rli[r]; }
  LAS float* xch = (LAS float*)lds + (size_t)rg * 128 * 64 + lane;
  if (s == 1) {
#pragma unroll
    for (int d = 0; d < 8; ++d)
#pragma unroll
      for (int r = 0; r < 16; ++r) xch[(d * 16 + r) * 64] = o[d][r];
  }
  __syncthreads();
  if (s == 0) {
    float ss[16];
#pragma unroll
    for (int r = 0; r < 16; ++r) ss[r] = 0.f;
#pragma unroll
    for (int d = 0; d < 8; ++d)
#pragma unroll
      for (int r = 0; r < 16; ++r) { const float v = o[d][r] - lam * xch[(d * 16 + r) * 64]; o[d][r] = v; ss[r] += v * v; }
#pragma unroll
    for (int r = 0; r < 16; ++r) { float v = ss[r]; v += swz_xor<1>(v); v += swz_xor<2>(v); v += swz_xor<4>(v); v += swz_xor<8>(v); v += swz_xor<16>(v);
      ss[r] = __builtin_amdgcn_rsqf(v * (1.0f / 256.0f) + EPS); }
    bf16_t* Ow = Ob + (size_t)(rg * 32) * ldo + r32;
#pragma unroll
    for (int d = 0; d < 8; ++d) { const float g = gvec[d * 32 + r32] * (1.0f - LAM_INIT);
#pragma unroll
      for (int r = 0; r < 16; ++r) Ow[(size_t)crow(r, hi) * ldo + d * 32] = (bf16_t)(cvtpk(o[d][r] * ss[r] * g, 0.f) & 0xffffu); }
  }
  __syncthreads();
}
constexpr int NA_BUF = 32768, NA_WS = 3 * NA_BUF, NA_TB = NA_WS + 8 * 64 * 4;
__device__ __forceinline__ void na_stage(LAS char* lds, int buf, const KV& kv, int t, int wid, int lane) {
  const bf16_t* kp; const bf16_t* vp; int lk, lv;
  if (t < kv.nt0) { lk = kv.ldk0; lv = kv.ldv0; kp = kv.k0 + (size_t)t * 64 * lk; vp = kv.v0 + (size_t)t * 64 * lv; }
  else { int j = kv.base1 + (t - kv.nt0); j = j < kv.max1 ? j : kv.max1; lk = kv.ldk1; lv = kv.ldv1; kp = kv.k1 + (size_t)j * 64 * lk; vp = kv.v1 + (size_t)j * 64 * lv; }
  const int w3 = wid & 3;
  if (wid < 4) {
    LAS char* dst = lds + buf * NA_BUF + w3 * 4096;
    const char* src = (const char*)(kp + (size_t)(w3 * 16) * lk);
    const int rl = lane >> 4, cp = lane & 15;
    const unsigned ve = (unsigned)(rl * lk) * 2u + (unsigned)((cp ^ rl) * 16), vo = (unsigned)(rl * lk) * 2u + (unsigned)((cp ^ (rl + 4)) * 16);
#pragma unroll
    for (int i = 0; i < 4; ++i) { const char* p = src + (size_t)(4 * i) * lk * 2;
      __builtin_amdgcn_global_load_lds((const unsigned*)(p + ((i & 1) ? vo : ve)), (LAS unsigned*)(dst + i * 1024), 16, 0, 0); }
  } else {
    LAS char* dst = lds + buf * NA_BUF + 16384 + w3 * 4096;
    const char* src = (const char*)vp;
    const int q3 = (lane & 31) >> 2;
    const unsigned vl = (unsigned)((q3 * lv + (lane >> 5) * 32 + (lane & 3) * 8) * 2);
#pragma unroll
    for (int i = 0; i < 4; ++i) { const int ku = (w3 * 2 + (i >> 1)) * 8;
      const char* p = src + ((size_t)ku * lv + (i & 1) * 64) * 2;
      __builtin_amdgcn_global_load_lds((const unsigned*)(p + vl), (LAS unsigned*)(dst + i * 1024), 16, 0, 0); }
  }
}
__device__ __forceinline__ void attn_body_na2(const bf16_t* __restrict__ Qb, int ldq, const KV kv, int NT, bf16_t* __restrict__ Ob, int ldo, LAS char* lds, const NaW naw) {
  const int tid = TIDX(), wid = __builtin_amdgcn_readfirstlane(tid >> 6), lane = tid & 63, r32 = lane & 31, hi = lane >> 5;
  LAS float* wsf = (LAS float*)(lds + NA_WS) + wid * 64; LAS float* li_l = wsf; LAS float* al_l = wsf + 32;
  float m_reg = 0.f, l_reg = 0; f32x16 o[4] = {}; bf16x8 qr[8];
  const bf16_t* Qw = Qb + (size_t)(wid * 32 + r32) * ldq + hi * 8;
#pragma unroll
  for (int d0 = 0; d0 < 8; ++d0) qr[d0] = *(const bf16x8*)(Qw + d0 * 16);
  const int vrd = v_rd_base(lane);
#define NBAR() do { asm volatile("" ::: "memory"); __builtin_amdgcn_s_barrier(); asm volatile("" ::: "memory"); } while (0)
  asm volatile("s_waitcnt vmcnt(0)" ::: "memory");
  na_stage(lds, 0, kv, 0, wid, lane); if (NT > 1) na_stage(lds, 1, kv, 1, wid, lane);
  if (NT > 1) asm volatile("s_waitcnt vmcnt(4) lgkmcnt(0)" ::: "memory"); else asm volatile("s_waitcnt vmcnt(0) lgkmcnt(0)" ::: "memory");
  NBAR();
  int b = 0;
  for (int t = 0; t < NT; ++t) {
    const int b2 = b == 0 ? 2 : b - 1;
    if (t + 2 < NT) na_stage(lds, b2, kv, t + 2, wid, lane);
    const int kr = naw.rsmin + (t - kv.nt0);
    const bool lat = t >= kv.nt0;
    if (!lat || (kr >= naw.rsq && kr < naw.rsq + 8)) {
      f32x16 p0, p1; float mn, al; bf16x8 pa0, pa1, pa2, pa3;
      qkt(p0, p1, lds + b * NA_BUF, qr, opq_v(r32), hi);
      if (lat) na_mask(p0, p1, kr, naw, hi);
      partialSM(p0, p1, m_reg, mn, al, l_reg);
      if (__any(al < 1.f)) { if (hi == 0) al_l[r32] = al; asm volatile("s_waitcnt lgkmcnt(0)" ::: "memory");
#pragma unroll
        for (int d = 0; d < 4; ++d)
#pragma unroll
          for (int r = 0; r < 16; ++r) o[d][r] *= al_l[crow(r, hi)]; }
      finishSM(p0, p1, al, l_reg, pa0, pa1, pa2, pa3); SBAR();
      pv_d0(o, (int)(uintptr_t)(lds + b * NA_BUF + 16384) + vrd, pa0, pa1, pa2, pa3);
    }
    asm volatile("s_waitcnt lgkmcnt(0)" ::: "memory");
    if (t + 2 < NT) asm volatile("s_waitcnt vmcnt(4)" ::: "memory"); else asm volatile("s_waitcnt vmcnt(0)" ::: "memory");
    NBAR();
    b = b == 2 ? 0 : b + 1;
  }
#undef NBAR
  if (hi == 0) li_l[r32] = l_reg; asm volatile("s_waitcnt lgkmcnt(0)" ::: "memory");
  float rli[16];
#pragma unroll
  for (int r = 0; r < 16; ++r) rli[r] = __builtin_amdgcn_rcpf(li_l[crow(r, hi)]);
  bf16_t* Ow = Ob + (size_t)(wid * 32) * ldo;
#pragma unroll
  for (int r = 0; r < 16; ++r) { const int orow = crow(r, hi);
#pragma unroll
    for (int d0 = 0; d0 < 4; ++d0) Ow[(size_t)orow * ldo + d0 * 32 + r32] = (bf16_t)(cvtpk(o[d0][r] * rli[r], 0.f) & 0xffffu); }
  asm volatile("s_waitcnt vmcnt(0)" ::: "memory");
}
}

#define XB_TMO      128
#define XB_XCNT(j)  (256  + 64 * (j))
#define XB_XSUB(j)  (1280 + 64 * (j))
#define XB_XGEN(j)  (2304 + 64 * (j))
#define XB_TOP      3328
#define XB_TOPGEN   3392
#define XCD_BAR_WORDS 3456
#define XB_SPIN_CAP (1u << 18)
__device__ __forceinline__ unsigned xb_ld(unsigned* p)              { return __hip_atomic_load(p, __ATOMIC_RELAXED, __HIP_MEMORY_SCOPE_AGENT); }
__device__ __forceinline__ unsigned xb_add(unsigned* p, unsigned v) { return __hip_atomic_fetch_add(p, v, __ATOMIC_RELAXED, __HIP_MEMORY_SCOPE_AGENT); }
__device__ __forceinline__ unsigned xb_xcc_id() { return (unsigned)__builtin_amdgcn_s_getreg((3 << 11) | 20) & 0xFu; }
#define XB_SPIN(cond, bar) do { unsigned _sp = 0; while (cond) { __builtin_amdgcn_s_sleep(1); \
    if ((++_sp & 255u) == 0u) { if (xb_ld(&(bar)[XB_TMO])) break; if (_sp > XB_SPIN_CAP) { atomicAdd(&(bar)[XB_TMO], 1u); break; } } } } while (0)
struct XcdBarrier { unsigned* bar; unsigned x; volatile LAS unsigned* st; };
__device__ __forceinline__ XcdBarrier xcd_barrier_post(unsigned* bar, volatile LAS unsigned* st) {
    XcdBarrier b; b.bar = bar; b.x = xb_xcc_id(); b.st = st;
    if (TIDX() == 0) (void)xb_add(&bar[XB_XCNT(b.x)], 1u);
    return b;
}
__device__ __forceinline__ void xcd_barrier_complete(unsigned* bar, unsigned x, unsigned& nloc, unsigned& nx) {
    const unsigned G = gridDim.x * gridDim.y * gridDim.z;
    unsigned sum, cnt, mine, sp = 0u;
    for (;;) {
        sum = 0u; cnt = 0u; mine = 0u;
#pragma unroll
        for (unsigned j = 0; j < 16; ++j) { const unsigned c = xb_ld(&bar[XB_XCNT(j)]); sum += c; cnt += (c > 0u) ? 1u : 0u; mine = (j == x) ? c : mine; }
        if (sum == G) break;
        __builtin_amdgcn_s_sleep(1);
        if ((++sp & 255u) == 0u) { if (xb_ld(&bar[XB_TMO])) break; if (sp > XB_SPIN_CAP) { atomicAdd(&bar[XB_TMO], 1u); break; } }
    }
    nloc = mine > 0u ? mine : 1u; nx = cnt > 0u ? cnt : 1u;
}
__device__ __forceinline__ void xcd_barrier(const XcdBarrier& b) {
    asm volatile("s_waitcnt vmcnt(0)" ::: "memory");
    __syncthreads();
    if (TIDX() == 0) {
        unsigned* bar = b.bar;
        __builtin_amdgcn_s_waitcnt(0);
        unsigned nloc = b.st[0], nx = b.st[1];
        if (nloc == 0u) { xcd_barrier_complete(bar, b.x, nloc, nx); b.st[0] = nloc; b.st[1] = nx; }
        const unsigned old = xb_add(&bar[XB_XSUB(b.x)], 1u);
        const unsigned gen = old / nloc;
        if (old + 1u == (gen + 1u) * nloc) {
            __builtin_amdgcn_fence(__ATOMIC_RELEASE, "agent");
            asm volatile("s_waitcnt vmcnt(0)" ::: "memory");
            const unsigned og = xb_add(&bar[XB_TOP], 1u);
            const unsigned tg = og / nx;
            if (og + 1u == (tg + 1u) * nx) xb_add(&bar[XB_TOPGEN], 1u);
            else XB_SPIN(xb_ld(&bar[XB_TOPGEN]) == tg, bar);
            __builtin_amdgcn_fence(__ATOMIC_ACQUIRE, "agent");
            xb_add(&bar[XB_XGEN(b.x)], 1u);
            asm volatile("s_waitcnt vmcnt(0)" ::: "memory");
        } else {
            XB_SPIN(xb_ld(&bar[XB_XGEN(b.x)]) == gen, bar);
            __builtin_amdgcn_fence(__ATOMIC_ACQUIRE, "agent");
            asm volatile("s_waitcnt vmcnt(0)" ::: "memory");
        }
    }
    __syncthreads();
}


__device__ __forceinline__ float wave_sum(float v) {
    v += swz_xor<1>(v); v += swz_xor<2>(v); v += swz_xor<4>(v); v += swz_xor<8>(v); v += swz_xor<16>(v);
    { auto rr = __builtin_amdgcn_permlane32_swap(__float_as_uint(v), __float_as_uint(v), false, false); v = __uint_as_float(rr[0]) + __uint_as_float(rr[1]); }
    return v;
}
__device__ __forceinline__ unsigned pk2(float lo, float hi) { return pg8::cvt_pk_bf16(lo, hi); }

struct Args { const float* in[26]; float* out; unsigned char* ws; int ph_lo, ph_hi; };

__device__ __forceinline__ void transpose_item(const float* W, int N, int K, bf16_t* WT, int k0, int n0, int r0a, int r0b, LAS float* scr, int lane) {
#pragma unroll 8
    for (int i = 0; i < 64; ++i) scr[i * 65 + lane] = W[(size_t)(k0 + i) * N + n0 + lane];
    asm volatile("s_waitcnt lgkmcnt(0)" ::: "memory");
    const int c = lane & 7;
#pragma unroll
    for (int j = 0; j < 8; ++j) { const int n = (lane >> 3) + 8 * j; const LAS float* s = scr + (8 * c) * 65 + n;
        u32x4 o; o.x = pk2(s[0 * 65], s[1 * 65]); o.y = pk2(s[2 * 65], s[3 * 65]); o.z = pk2(s[4 * 65], s[5 * 65]); o.w = pk2(s[6 * 65], s[7 * 65]);
        const int row = (j < 4 ? r0a : r0b - 32) + n;
        const int nl = row & 127, p = nl & 31, R = (nl & ~31) + ((p >> 2) & 1) * 16 + (p >> 3) * 4 + (p & 3);
        *(u32x4*)((char*)WT + (((size_t)(row >> 8) * (K >> 6) + (k0 >> 6)) * 2 + ((row >> 7) & 1)) * 16384 + pg8::lds_byte(R, 8 * c)) = o; }
    asm volatile("s_waitcnt lgkmcnt(0)" ::: "memory");
}
template <int MAP> __device__ __forceinline__ int map_row32(int n32) {
    if (MAP == 1) return (n32 >> 7) * 256 + (n32 & 127);
    if (MAP == 2) return (n32 >> 7) * 256 + 128 + (n32 & 127);
    if (MAP == 3) { if (n32 >= 4096) return n32; const int t = n32 >> 8, hp = (n32 >> 7) & 1, part = (n32 >> 6) & 1, x = (n32 >> 5) & 1; return t * 256 + x * 128 + hp * 64 + part * 32; }
    return n32;
}
template <int MAP> __device__ __forceinline__ void transpose_matrix(const float* W, int K, int N, bf16_t* WT, int gw, int ngw, LAS float* scr, int lane) {
    const int nbn = N / 64, nit = (K / 64) * nbn;
    for (int it = gw; it < nit; it += ngw) { const int kb = it / nbn, nb = it % nbn;
        transpose_item(W, N, K, WT, kb * 64, nb * 64, map_row32<MAP>(nb * 64), map_row32<MAP>(nb * 64 + 32), scr, lane); }
}
__device__ __forceinline__ void cvt_array(const float* src, bf16_t* dst, size_t n8, size_t gt, size_t ngt) {
    for (size_t i = gt; i < n8; i += ngt) { const f32x4 a = *(const f32x4*)(src + i * 8), b = *(const f32x4*)(src + i * 8 + 4);
        u32x4 w; w.x = pk2(a[0], a[1]); w.y = pk2(a[2], a[3]); w.z = pk2(b[0], b[1]); w.w = pk2(b[2], b[3]); *(u32x4*)(dst + i * 8) = w; }
}

__device__ __forceinline__ void phase_prologue(const Args& a, LAS unsigned char* lds, int vcu, int G) {
    const int tid = TIDX(), lane = tid & 63, wave = tid >> 6;
    unsigned char* ws = a.ws;
    if (vcu < 144) {
        LAS float* sc = (LAS float*)lds;
        LAS f32x4* red = (LAS f32x4*)(lds + 65536);
        for (int i = tid; i < 2048 * 8; i += 512) { const int k = i >> 3, b = i & 7; float v = 0.f;
            if (b < 5) { const float x = (b == 0) ? a.in[7][k] : a.in[2][(b - 1) * 2048 + k]; v = x / (1.0f + __expf(-x)); }
            sc[i] = v; }
        __syncthreads();
        for (int u = vcu; u < 144; u += G) {
            const int l = u / 72, cg = u % 72;
            const float* W = a.in[8] + (size_t)l * 2048 * 18432 + cg * 256 + lane * 4;
            f32x4 acc[5];
#pragma unroll
            for (int b = 0; b < 5; ++b) acc[b] = (f32x4){0.f, 0.f, 0.f, 0.f};
            const int kb = wave * 256;
#pragma unroll 8
            for (int k = 0; k < 256; ++k) { const f32x4 wv = *(const f32x4*)(W + (size_t)(kb + k) * 18432);
                const f32x4 s03 = *(const LAS f32x4*)(sc + (kb + k) * 8); const float s4 = sc[(kb + k) * 8 + 4];
                acc[0] += wv * s03[0]; acc[1] += wv * s03[1]; acc[2] += wv * s03[2]; acc[3] += wv * s03[3]; acc[4] += wv * s4; }
#pragma unroll
            for (int b = 0; b < 5; ++b) red[(wave * 5 + b) * 64 + lane] = acc[b];
            __syncthreads();
            if (tid < 320) { const int b = tid >> 6; f32x4 s = red[b * 64 + lane];
#pragma unroll
                for (int w = 1; w < 8; ++w) s += red[(w * 5 + b) * 64 + lane];
                const int n = cg * 256 + lane * 4;
                s += *(const f32x4*)(a.in[9] + (size_t)l * 18432 + n);
                *(f32x4*)((float*)(ws + WS_MOD) + ((size_t)l * 5 + b) * 18432 + n) = s; }
            __syncthreads();
        }
    }
    __syncthreads();
    const int ngw = G * 8; const int gw = ((vcu + 112) % G) * 8 + wave;
    LAS float* scr = (LAS float*)(lds + wave * 16640);
    for (int li = 0; li < 4; ++li) {
        transpose_matrix<1>(a.in[11] + (size_t)li * DM * DFF, DM, DFF, (bf16_t*)(ws + WS_W13 + li * W13_BYTES), gw, ngw, scr, lane);
        transpose_matrix<2>(a.in[12] + (size_t)li * DM * DFF, DM, DFF, (bf16_t*)(ws + WS_W13 + li * W13_BYTES), gw, ngw, scr, lane);
        transpose_matrix<0>(a.in[13] + (size_t)li * DFF * DM, DFF, DM, (bf16_t*)(ws + WS_W2 + li * W2_BYTES), gw, ngw, scr, lane);
    }
    transpose_matrix<0>(a.in[14], DM, INA, (bf16_t*)(ws + WS_WINA), gw, ngw, scr, lane);
    transpose_matrix<3>(a.in[21], DM, INC, (bf16_t*)(ws + WS_WINC), gw, ngw, scr, lane);
    transpose_matrix<0>(a.in[15], DM, DM, (bf16_t*)(ws + WS_WOA), gw, ngw, scr, lane);
    transpose_matrix<0>(a.in[22], DM, DM, (bf16_t*)(ws + WS_WOC), gw, ngw, scr, lane);
    const size_t gt = (size_t)vcu * 512 + tid, ngt = (size_t)G * 512;
    cvt_array(a.in[3], (bf16_t*)(ws + WS_CAK), 2097152 / 8, gt, ngt);
    cvt_array(a.in[4], (bf16_t*)(ws + WS_CAV), 2097152 / 8, gt, ngt);
    cvt_array(a.in[5], (bf16_t*)(ws + WS_CCK), 4194304 / 8, gt, ngt);
    cvt_array(a.in[6], (bf16_t*)(ws + WS_CCV), 4194304 / 8, gt, ngt);
    if (gt < 2048) { const int pos = (int)gt >> 5, i = (int)gt & 31; const float inv = powf(10000.0f, -(float)i / 32.0f); const float ang = (float)pos * inv;
        ((float*)(ws + WS_ROPE))[gt] = cosf(ang); ((float*)(ws + WS_ROPE))[2048 + gt] = sinf(ang); }
}

__device__ __forceinline__ char* h_tiled(bf16_t* H, int row, int col) {
    return (char*)H + (((size_t)(row >> 8) * (DM / 64) + (col >> 6)) * 2 + ((row >> 7) & 1)) * 16384 + pg8::lds_byte(row & 127, col & 63);
}
__device__ __forceinline__ void load_xrow(const Args& a, int first, int row, int lane, f32x4 (&v)[8]) {
    if (first) { const float* xr = row < NCTX ? a.in[0] + (size_t)row * DM : a.in[1] + (size_t)(row - NCTX) * DM;
#pragma unroll
        for (int j = 0; j < 8; ++j) v[j] = *(const f32x4*)(xr + 4 * lane + 256 * j);
    } else { const bf16_t* xr = (const bf16_t*)(a.ws + WS_X) + (size_t)row * XS;
#pragma unroll
        for (int j = 0; j < 8; ++j) { const u32x2 w = *(const u32x2*)(xr + 4 * lane + 256 * j);
            v[j] = (f32x4){__uint_as_float(w.x << 16), __uint_as_float(w.x & 0xffff0000u), __uint_as_float(w.y << 16), __uint_as_float(w.y & 0xffff0000u)}; } }
}
__device__ __forceinline__ void phase_norm(const Args& a, int vcu, int G, int first, int l, int sub) {
    const int tid = TIDX(), lane = tid & 63, wave = tid >> 6;
    const int gw = vcu * 8 + wave, ngw = G * 8;
    const int rows_per = (MTOK + ngw - 1) / ngw;
    const float* gvec = a.in[10] + ((size_t)l * 3 + sub) * DM;
    const float* mbase = (const float*)(a.ws + WS_MOD) + (size_t)l * 5 * 18432 + (size_t)(3 * sub) * DM;
    bf16_t* H = (bf16_t*)(a.ws + WS_H);
    int cur_mi = -1; f32x4 A[8], B[8], vn[8];
    if (gw * rows_per < MTOK) load_xrow(a, first, gw * rows_per, lane, vn);
    for (int rr = 0; rr < rows_per; ++rr) {
        const int row = gw * rows_per + rr; if (row >= MTOK) break;
        const int mi = row < NCTX ? 0 : 1 + ((row - NCTX) >> 12);
        if (mi != cur_mi) { cur_mi = mi; const float* mv = mbase + (size_t)mi * 18432;
#pragma unroll
            for (int j = 0; j < 8; ++j) { const int c = 4 * lane + 256 * j; const f32x4 g = *(const f32x4*)(gvec + c), sh = *(const f32x4*)(mv + c), scl = *(const f32x4*)(mv + DM + c);
                A[j] = g * (1.0f + scl); B[j] = sh; } }
        f32x4 v[8]; float s = 0.f;
#pragma unroll
        for (int j = 0; j < 8; ++j) v[j] = vn[j];
        if (rr + 1 < rows_per && row + 1 < MTOK) load_xrow(a, first, row + 1, lane, vn);
#pragma unroll
        for (int j = 0; j < 8; ++j) s += (v[j][0] * v[j][0] + v[j][1] * v[j][1]) + (v[j][2] * v[j][2] + v[j][3] * v[j][3]);
        const float rstd = 1.0f / sqrtf(wave_sum(s) * (1.0f / DM) + EPS);
        bf16_t* hr = H + (size_t)row * DM;
#pragma unroll
        for (int j = 0; j < 8; ++j) { const f32x4 y = v[j] * rstd * A[j] + B[j]; u32x2 w; w.x = pk2(y[0], y[1]); w.y = pk2(y[2], y[3]); *(u32x2*)(hr + 4 * lane + 256 * j) = w; }
    }
}
__device__ __forceinline__ void load_xrow_packed(const Args& a, int row, int lane, u32x2 (&p)[8]) {
    const bf16_t* xr = (const bf16_t*)(a.ws + WS_X) + (size_t)row * XS;
#pragma unroll
    for (int j = 0; j < 8; ++j) p[j] = *(const u32x2*)(xr + 4 * lane + 256 * j);
}
__device__ __forceinline__ void phase_norm_pairs(const Args& a, int vcu, int G, int l, int sub) {
    const int tid = TIDX(), lane = tid & 63, wave = tid >> 6;
    const int gw = vcu * 8 + wave, ngw = G * 8;
    const int rows_per = (MTOK + ngw - 1) / ngw;
    const float* gvec = a.in[10] + ((size_t)l * 3 + sub) * DM;
    const float* mbase = (const float*)(a.ws + WS_MOD) + (size_t)l * 5 * 18432 + (size_t)(3 * sub) * DM;
    bf16_t* H = (bf16_t*)(a.ws + WS_H);
    int cur_mi = -1; f32x4 A[8], B[8]; u32x2 pn0[8], pn1[8];
    const int rbase = gw * rows_per;
    if (rbase < MTOK) load_xrow_packed(a, rbase, lane, pn0);
    if (rows_per > 1 && rbase + 1 < MTOK) load_xrow_packed(a, rbase + 1, lane, pn1);
    for (int rr = 0; rr < rows_per; rr += 2) {
        const int row = rbase + rr; if (row >= MTOK) break;
        const bool two = (rr + 1 < rows_per) && (row + 1 < MTOK);
        u32x2 p0[8], p1[8];
#pragma unroll
        for (int j = 0; j < 8; ++j) { p0[j] = pn0[j]; p1[j] = pn1[j]; }
        if (rr + 2 < rows_per && row + 2 < MTOK) load_xrow_packed(a, row + 2, lane, pn0);
        if (rr + 3 < rows_per && row + 3 < MTOK) load_xrow_packed(a, row + 3, lane, pn1);
#pragma unroll
        for (int h = 0; h < 2; ++h) {
            if (h == 1 && !two) break;
            const int r = row + h;
            const int mi = r < NCTX ? 0 : 1 + ((r - NCTX) >> 12);
            if (mi != cur_mi) { cur_mi = mi; const float* mv = mbase + (size_t)mi * 18432;
#pragma unroll
                for (int j = 0; j < 8; ++j) { const int c = 4 * lane + 256 * j; const f32x4 g = *(const f32x4*)(gvec + c), sh = *(const f32x4*)(mv + c), scl = *(const f32x4*)(mv + DM + c);
                    A[j] = g * (1.0f + scl); B[j] = sh; } }
            f32x4 v[8]; float s = 0.f;
#pragma unroll
            for (int j = 0; j < 8; ++j) { const u32x2 w = h ? p1[j] : p0[j];
                v[j] = (f32x4){__uint_as_float(w.x << 16), __uint_as_float(w.x & 0xffff0000u), __uint_as_float(w.y << 16), __uint_as_float(w.y & 0xffff0000u)};
                s += (v[j][0] * v[j][0] + v[j][1] * v[j][1]) + (v[j][2] * v[j][2] + v[j][3] * v[j][3]); }
            const float rstd = 1.0f / sqrtf(wave_sum(s) * (1.0f / DM) + EPS);
            bf16_t* hr = H + (size_t)r * DM;
#pragma unroll
            for (int j = 0; j < 8; ++j) { const f32x4 y = v[j] * rstd * A[j] + B[j]; u32x2 w; w.x = pk2(y[0], y[1]); w.y = pk2(y[2], y[3]); *(u32x2*)(hr + 4 * lane + 256 * j) = w; }
        }
    }
}
template <bool FIRST> __device__ __forceinline__ void phase_norm_tiled(const Args& a, LAS unsigned char* lds, int vcu, int G, int l, int sub) {
    const int tid = TIDX(), lane = tid & 63, wave = tid >> 6;
    const float* gvec = a.in[10] + ((size_t)l * 3 + sub) * DM;
    const float* mbase = (const float*)(a.ws + WS_MOD) + (size_t)l * 5 * 18432 + (size_t)(3 * sub) * DM;
    char* H = (char*)(a.ws + WS_H);
    const int base = vcu * (MTOK / G);
    int cur_mi = -1; f32x4 A[8], B[8]; u32x2 pn0[8], pn1[8];
    if (!FIRST) { load_xrow_packed(a, base + 2 * wave, lane, pn0); load_xrow_packed(a, base + 2 * wave + 1, lane, pn1); }
    for (int k = 0; k < (MTOK / G) / 16; ++k) {
        const int r0 = base + 16 * k + 2 * wave;
        u32x2 p0[8], p1[8];
        if (!FIRST) {
#pragma unroll
            for (int j = 0; j < 8; ++j) { p0[j] = pn0[j]; p1[j] = pn1[j]; }
            if (k + 1 < (MTOK / G) / 16) { load_xrow_packed(a, r0 + 16, lane, pn0); load_xrow_packed(a, r0 + 17, lane, pn1); } }
#pragma unroll
        for (int h = 0; h < 2; ++h) {
            const int r = r0 + h;
            const int mi = r < NCTX ? 0 : 1 + ((r - NCTX) >> 12);
            if (mi != cur_mi) { cur_mi = mi; const float* mv = mbase + (size_t)mi * 18432;
#pragma unroll
                for (int j = 0; j < 8; ++j) { const int c = 4 * lane + 256 * j; const f32x4 g = *(const f32x4*)(gvec + c), sh = *(const f32x4*)(mv + c), scl = *(const f32x4*)(mv + DM + c);
                    A[j] = g * (1.0f + scl); B[j] = sh; } }
            f32x4 v[8]; float s = 0.f;
            if (FIRST) load_xrow(a, 1, r, lane, v);
#pragma unroll
            for (int j = 0; j < 8; ++j) {
                if (!FIRST) { const u32x2 w = h ? p1[j] : p0[j];
                    v[j] = (f32x4){__uint_as_float(w.x << 16), __uint_as_float(w.x & 0xffff0000u), __uint_as_float(w.y << 16), __uint_as_float(w.y & 0xffff0000u)}; }
                s += (v[j][0] * v[j][0] + v[j][1] * v[j][1]) + (v[j][2] * v[j][2] + v[j][3] * v[j][3]); }
            const float rstd = 1.0f / sqrtf(wave_sum(s) * (1.0f / DM) + EPS);
            const int rl = 2 * wave + h, cc = 4 * (lane & 15);
            const int ob = rl * 64 + (cc & 31) * 2, so = (cc >> 5) * 1024 + (ob ^ (((ob >> 9) & 1) << 5));
#pragma unroll
            for (int j = 0; j < 8; ++j) { const f32x4 y = v[j] * rstd * A[j] + B[j]; u32x2 w; w.x = pk2(y[0], y[1]); w.y = pk2(y[2], y[3]);
                *(LAS u32x2*)(lds + ((lane >> 4) + 4 * j) * 2048 + so) = w; }
        }
        __syncthreads();
        { const int row = base + 16 * k;
          char* dst = H + (((size_t)(row >> 8) * (DM / 64)) * 2 + ((row >> 7) & 1)) * 16384 + ((row >> 4) & 7) * 2048;
#pragma unroll
          for (int i = 0; i < 8; ++i) { const int q = tid + 512 * i;
              *(u32x4*)(dst + (size_t)(q >> 7) * 32768 + (q & 127) * 16) = *(const LAS u32x4*)(lds + q * 16); } }
        __syncthreads();
    }
}

__device__ __forceinline__ void phase_final(const Args& a, int vcu, int G) {
    const int tid = TIDX(), lane = tid & 63, wave = tid >> 6;
    const int gw = vcu * 8 + wave, ngw = G * 8;
    const float* g = a.in[25];
    f32x4 gv[8];
#pragma unroll
    for (int j = 0; j < 8; ++j) gv[j] = *(const f32x4*)(g + 4 * lane + 256 * j);
    f32x4 vn[8];
    if (gw < MTOK) load_xrow(a, 0, gw, lane, vn);
    for (int row = gw; row < MTOK; row += ngw) {
        f32x4 v[8]; float s = 0.f;
#pragma unroll
        for (int j = 0; j < 8; ++j) v[j] = vn[j];
        if (row + ngw < MTOK) load_xrow(a, 0, row + ngw, lane, vn);
#pragma unroll
        for (int j = 0; j < 8; ++j) s += (v[j][0] * v[j][0] + v[j][1] * v[j][1]) + (v[j][2] * v[j][2] + v[j][3] * v[j][3]);
        const float rstd = 1.0f / sqrtf(wave_sum(s) * (1.0f / DM) + EPS);
        float* orow = a.out + (size_t)row * DM;
#pragma unroll
        for (int j = 0; j < 8; ++j) *(f32x4*)(orow + 4 * lane + 256 * j) = v[j] * rstd * gv[j];
    }
}

__device__ __forceinline__ float bf_lo(unsigned u) { return __uint_as_float(u << 16); }
__device__ __forceinline__ float bf_hi(unsigned u) { return __uint_as_float(u & 0xffff0000u); }
__device__ __forceinline__ float ldu_f32(const float* ubase, unsigned voff_bytes) { return *(const float*)((const char*)ubase + voff_bytes); }
__device__ __forceinline__ float glu1(float av, float gv) { return av * __builtin_amdgcn_rcpf(1.0f + __builtin_amdgcn_exp2f(-1.4426950408889634f * gv)); }
__device__ __forceinline__ void conv_item(const Args& a, LAS unsigned char* lds, int item) {
    const int tid = TIDX(), lane = tid & 63, wave = tid >> 6;
    const bf16_t* QKV = (const bf16_t*)(a.ws + WS_U); bf16_t* AO = (bf16_t*)(a.ws + WS_AO);
    const int t0 = item * 16;
    const int seq_lo = t0 < NCTX ? (t0 & ~255) : NCTX + ((t0 - NCTX) & ~4095);
    const int seq_hi = t0 < NCTX ? seq_lo + 256 : seq_lo + 4096;
    LAS float* zs = (LAS float*)lds;
    LAS float* os = (LAS float*)(lds + 49152);
    LAS float* st = (LAS float*)(lds + 49152 + 65536);
    LAS float* st2 = st + 128;
    const int ch = tid & 255, half = tid >> 8;
    float psum[8], psq[8];
#pragma unroll
    for (int i = 0; i < 8; ++i) { psum[i] = 0.f; psq[i] = 0.f; }
    u32x4 av[3], gv[3]; float wreg[31], bias; float wnext[31], bnext; u32x4 avn[3], gvn[3];
    bool okk[3];
#pragma unroll
    for (int k = 0; k < 3; ++k) { const int g = tid + 512 * k, row = g >> 5, tok = t0 - 15 + row; okk[k] = (g < 1472) && tok >= seq_lo && tok < seq_hi; }
#define CONV_LOAD(cc_, AV, GV, WR, BI) do { _Pragma("unroll") for (int k = 0; k < 3; ++k) { const int g = tid + 512 * k; int row = g >> 5; row = row > 45 ? 45 : row; const int c8 = (g & 31) * 8; int tok = t0 - 15 + row; \
        tok = tok < seq_lo ? seq_lo : (tok >= seq_hi ? seq_hi - 1 : tok); const bf16_t* p = QKV + (size_t)tok * INA + 3072 + (cc_) * 256 + c8; AV[k] = *(const u32x4*)p; GV[k] = *(const u32x4*)(p + 1024); } \
        { const float* wp_ = a.in[17] + (cc_) * 256 + ch; _Pragma("unroll") for (int w = 0; w < 31; ++w) WR[w] = wp_[w * 1024]; BI = a.in[18][(cc_) * 256 + ch]; } } while (0)
    CONV_LOAD(0, av, gv, wreg, bias);
#pragma unroll 1
    for (int cc = 0; cc < 4; ++cc) {
        const int c = cc * 256 + ch;
        __syncthreads();
#pragma unroll
        for (int k = 0; k < 3; ++k) { const int g = tid + 512 * k, row = g >> 5, c8 = (g & 31) * 8;
            if (g < 1472) { f32x4 z0, z1; const u32x4 A_ = okk[k] ? av[k] : (u32x4){0u, 0u, 0u, 0u}; const u32x4 G_ = gv[k];
                z0[0] = glu1(bf_lo(A_.x), bf_lo(G_.x)); z0[1] = glu1(bf_hi(A_.x), bf_hi(G_.x)); z0[2] = glu1(bf_lo(A_.y), bf_lo(G_.y)); z0[3] = glu1(bf_hi(A_.y), bf_hi(G_.y));
                z1[0] = glu1(bf_lo(A_.z), bf_lo(G_.z)); z1[1] = glu1(bf_hi(A_.z), bf_hi(G_.z)); z1[2] = glu1(bf_lo(A_.w), bf_lo(G_.w)); z1[3] = glu1(bf_hi(A_.w), bf_hi(G_.w));
                *(LAS f32x4*)(zs + row * 256 + c8) = z0; *(LAS f32x4*)(zs + row * 256 + c8 + 4) = z1; } }
        __syncthreads();
        { const int cn = cc < 3 ? cc + 1 : 3; CONV_LOAD(cn, avn, gvn, wnext, bnext); }
        float acc[8];
#pragma unroll
        for (int i = 0; i < 8; ++i) acc[i] = bias;
#pragma unroll
        for (int j = 0; j < 38; ++j) { const float z = zs[(half * 8 + j) * 256 + ch];
#pragma unroll
            for (int i = 0; i < 8; ++i) { const int w = j - i; if (w >= 0 && w < 31) acc[i] = fmaf(z, wreg[w], acc[i]); } }
#pragma unroll
        for (int i = 0; i < 8; ++i) { os[(half * 8 + i) * 1024 + c] = acc[i]; psum[i] += acc[i]; psq[i] += acc[i] * acc[i]; }
#pragma unroll
        for (int k = 0; k < 3; ++k) { av[k] = avn[k]; gv[k] = gvn[k]; }
#pragma unroll
        for (int w = 0; w < 31; ++w) wreg[w] = wnext[w];
        bias = bnext;
    }
#undef CONV_LOAD
#pragma unroll
    for (int i = 0; i < 8; ++i) { const float s = wave_sum(psum[i]), q = wave_sum(psq[i]); if (lane == 0) { st[(wave * 8 + i) * 2] = s; st[(wave * 8 + i) * 2 + 1] = q; } }
    __syncthreads();
    if (tid < 16) { const int hf = tid >> 3, i = tid & 7; float s = 0.f, q = 0.f;
#pragma unroll
        for (int w = 0; w < 4; ++w) { s += st[((hf * 4 + w) * 8 + i) * 2]; q += st[((hf * 4 + w) * 8 + i) * 2 + 1]; }
        const float mean = s * (1.0f / 1024.0f), var = q * (1.0f / 1024.0f) - mean * mean;
        st2[tid * 2] = mean; st2[tid * 2 + 1] = 1.0f / sqrtf(var + EPS); }
    __syncthreads();
    { const int c8 = (tid & 127) * 8, tq = tid >> 7;
      const f32x4 g0 = *(const f32x4*)(a.in[19] + c8), g1 = *(const f32x4*)(a.in[19] + c8 + 4), b0 = *(const f32x4*)(a.in[20] + c8), b1 = *(const f32x4*)(a.in[20] + c8 + 4);
#pragma unroll
      for (int k = 0; k < 4; ++k) { const int t = tq * 4 + k; const f32x4 v0 = *(const LAS f32x4*)(os + t * 1024 + c8), v1 = *(const LAS f32x4*)(os + t * 1024 + c8 + 4);
        const float mean = st2[t * 2], rstd = st2[t * 2 + 1];
        f32x4 y0 = (v0 - mean) * rstd * g0 + b0, y1 = (v1 - mean) * rstd * g1 + b1;
#pragma unroll
        for (int e = 0; e < 4; ++e) { y0[e] = y0[e] * __builtin_amdgcn_rcpf(1.0f + __builtin_amdgcn_exp2f(-1.4426950408889634f * y0[e])); y1[e] = y1[e] * __builtin_amdgcn_rcpf(1.0f + __builtin_amdgcn_exp2f(-1.4426950408889634f * y1[e])); }
        u32x4 w; w.x = pk2(y0[0], y0[1]); w.y = pk2(y0[2], y0[3]); w.z = pk2(y1[0], y1[1]); w.w = pk2(y1[2], y1[3]);
        *(u32x4*)(AO + (size_t)(t0 + t) * DM + 1024 + c8) = w; } }
    __syncthreads();
}

#ifndef SD_DENSE
#define SD_DENSE 2
#endif
__device__ __forceinline__ void phase_mix_even(const Args& a, LAS unsigned char* lds, int vcu, int G) {
    const int tid = TIDX();
    const bf16_t* QKV = (const bf16_t*)(a.ws + WS_U); bf16_t* AO = (bf16_t*)(a.ws + WS_AO);
    const bf16_t* CAK = (const bf16_t*)(a.ws + WS_CAK); const bf16_t* CAV = (const bf16_t*)(a.ws + WS_CAV);
    for (int it = vcu; it < 512; it += G) {
        const int qb = it & 15, h = (it >> 4) & 7, b = it >> 7;
        LAS float* tb = (LAS float*)(lds + att::NA_TB);
        for (int i = tid; i < 465; i += 512) tb[i] = a.in[16][h * 465 + i] * 1.4426950408889634f;
        const int r0 = qb * 4; int rsmin = r0 - 4; rsmin = rsmin < 0 ? 0 : (rsmin > 56 ? 56 : rsmin);
        const int wid = tid >> 6, lane = tid & 63;
        att::NaW w; w.qrow = r0 + (wid >> 1); int rsq = w.qrow - 4; w.rsq = rsq < 0 ? 0 : (rsq > 56 ? 56 : rsq);
        w.c = (wid & 1) * 32 + (lane & 31); int cs = w.c - 8; w.cs = cs < 0 ? 0 : (cs > 48 ? 48 : cs); w.rsmin = rsmin; w.tb = tb;
        const size_t lat0 = (size_t)(NCTX + b * 4096);
        att::KV kv; kv.k0 = CAK + (size_t)(b * 8 + h) * 512 * 128; kv.v0 = CAV + (size_t)(b * 8 + h) * 512 * 128; kv.ldk0 = 128; kv.ldv0 = 128; kv.nt0 = 8;
        kv.k1 = QKV + lat0 * INA + 1024 + h * 128; kv.v1 = QKV + lat0 * INA + 2048 + h * 128; kv.ldk1 = INA; kv.ldv1 = INA; kv.base1 = rsmin; kv.max1 = 63;
        att::attn_body_na2(QKV + (lat0 + qb * 256) * INA + h * 128, INA, kv, 19, AO + (lat0 + qb * 256) * DM + h * 128, DM, (LAS char*)lds, w);
    }
    for (int it = vcu; it < 128; it += G) {
        const int h = it & 7, b = it >> 3; const size_t r0 = (size_t)b * 256;
        att::KV kv; kv.k0 = QKV + r0 * INA + 1024 + h * 128; kv.v0 = QKV + r0 * INA + 2048 + h * 128; kv.ldk0 = INA; kv.ldv0 = INA; kv.nt0 = 4;
        kv.k1 = kv.k0; kv.v1 = kv.v0; kv.ldk1 = INA; kv.ldv1 = INA; kv.base1 = 0; kv.max1 = 0;
        att::NaW w{};
        att::attn_body<0, SD_DENSE>(QKV + r0 * INA + h * 128, INA, kv, 4, AO + r0 * DM + h * 128, DM, (LAS char*)lds, w);
    }
    __syncthreads();
    for (int it = vcu; it < MTOK / 16; it += G) conv_item(a, lds, it);
}
__device__ __forceinline__ void phase_mix_odd(const Args& a, LAS unsigned char* lds, int vcu, int G) {
    const bf16_t* QKV = (const bf16_t*)(a.ws + WS_U); bf16_t* AO = (bf16_t*)(a.ws + WS_AO);
    const bf16_t* CCK = (const bf16_t*)(a.ws + WS_CCK); const bf16_t* CCV = (const bf16_t*)(a.ws + WS_CCV);
    const int lane = TIDX() & 63;
    const float* lp = a.in[23];
    float s1 = lp[lane] * lp[128 + lane] + lp[64 + lane] * lp[192 + lane], s2 = lp[256 + lane] * lp[384 + lane] + lp[320 + lane] * lp[448 + lane];
    s1 = wave_sum(s1); s2 = wave_sum(s2);
    const float lam = expf(s1) - expf(s2) + LAM_INIT;
    for (int it = vcu; it < 1024; it += G) {
        const int qb = it & 31, h = (it >> 5) & 7, b = it >> 8;
        const size_t lat0 = (size_t)(NCTX + b * 4096);
        att::DKV sa, sb;
        sa.k0 = CCK + (size_t)(b * 16 + 2 * h) * 512 * 128; sa.k1 = sa.k0 + 512 * 128; sa.v = CCV + (size_t)(b * 8 + h) * 512 * 256; sa.ldk = 128; sa.ldv = 256; sa.nt = 8;
        sb.k0 = QKV + lat0 * INC + 2048 + 2 * h * 128; sb.k1 = sb.k0 + 128; sb.v = QKV + lat0 * INC + 4096 + h * 256; sb.ldk = INC; sb.ldv = INC; sb.nt = 64;
        att::attn_diff_body(QKV + (lat0 + qb * 128) * INC + 2 * h * 128, INC, sa, sb, AO + (lat0 + qb * 128) * DM + h * 256, DM, (LAS char*)lds, lam, a.in[24]);
    }
    for (int it = vcu; it < 256; it += G) {
        const int qb = it & 1, h = (it >> 1) & 7, b = it >> 4; const size_t r0 = (size_t)b * 256;
        att::DKV sa, sb;
        sa.k0 = QKV + r0 * INC + 2048 + 2 * h * 128; sa.k1 = sa.k0 + 128; sa.v = QKV + r0 * INC + 4096 + h * 256; sa.ldk = INC; sa.ldv = INC; sa.nt = 4;
        sb = sa; sb.nt = 0;
        att::attn_diff_body(QKV + (r0 + qb * 128) * INC + 2 * h * 128, INC, sa, sb, AO + (r0 + qb * 128) * DM + h * 256, DM, (LAS char*)lds, lam, a.in[24]);
    }
}
constexpr int N_PHASES = 22;
#ifndef PHM
#define PHM 0xffff
#endif
#ifndef REPM
#define REPM 0
#endif
#define NREP(bit) ((REPM & (bit)) ? 2 : 1)
__global__ void __launch_bounds__(512, 2) mk_fwd(Args a) {
    LAS unsigned char* lds = (LAS unsigned char*)mk_lds;
    { const unsigned slot = (unsigned)__builtin_amdgcn_s_getreg(((6 - 1) << 11) | 4) & 63u; if ((threadIdx.x & 63) == 0) ((LAS int*)(lds + WTAB_OFF))[slot] = (int)(threadIdx.x >> 6); }
    __syncthreads();
    const int tid = TIDX();
    const int G = gridDim.x, bx = blockIdx.x; const int vcu = (G % 8 == 0) ? (bx % 8) * (G / 8) + bx / 8 : bx;
    volatile LAS unsigned* MISC = (volatile LAS unsigned*)(lds + MISC_OFF);
    if (tid < 32) MISC[tid] = 0u;
    __syncthreads();
    const int lo = a.ph_lo, hi = a.ph_hi;
    unsigned* ctl = (unsigned*)(a.ws + WS_CTL);
    XcdBarrier bar; bar.bar = ctl + CW_BAR; bar.x = 0; bar.st = MISC + 8;
    if (hi - lo > 1) bar = xcd_barrier_post(ctl + CW_BAR, MISC + 8);
    int ph = 0;
#define RUN() (ph >= lo && ph < hi)
#ifndef SEAM_REP
#define SEAM_REP 1
#endif
#define SEAM() do { if (ph >= lo && ph + 1 < hi) { for (int sr_ = 0; sr_ < SEAM_REP; ++sr_) xcd_barrier(bar); } ++ph; } while (0)
    unsigned char* ws = a.ws;
    bf16_t* X = (bf16_t*)(ws + WS_X);
    const float* MODV = (const float*)(ws + WS_MOD);

    if ((PHM & 1) && RUN()) for (int rep = 0; rep < NREP(1); ++rep) phase_prologue(a, lds, vcu, G);
    SEAM();
    for (int s = 0; s < 4; ++s) {
        const int l = s >> 1, half = s & 1, li = s, first = (s == 0);
        if ((PHM & 2) && RUN()) for (int rep = 0; rep < NREP(2); ++rep) { if (first) phase_norm_tiled<true>(a, lds, vcu, G, l, 0); else phase_norm_tiled<false>(a, lds, vcu, G, l, half ? 2 : 0); }
        SEAM();
        if ((PHM & 4) && RUN()) for (int rep = 0; rep < NREP(4); ++rep) { pg8::Gemm g{(const bf16_t*)(ws + WS_H), (const bf16_t*)(ws + WS_W13 + (size_t)li * W13_BYTES), MTOK, 2 * DFF, DM, 1};
            pg8::StaticOrder S; S.init(MTOK, 2 * DFF, DM, G, bx, WGM_UP); EpiSwiglu E{(bf16_t*)(ws + WS_U)};
            pg8::gemm_phase<EpiSwiglu, pg8::StaticOrder, true, true>(lds, g, S, E); }
        SEAM();
        if ((PHM & 8) && RUN()) for (int rep = 0; rep < NREP(8); ++rep) { pg8::Gemm g{(const bf16_t*)(ws + WS_U), (const bf16_t*)(ws + WS_W2 + (size_t)li * W2_BYTES), MTOK, DM, DFF, 1};
            pg8::DnOrder S; S.init(DFF, bx);
            EpiResid E{a.in[0], a.in[1], X, MODV + (size_t)l * 5 * 18432 + (size_t)(half ? 8 : 2) * DM, 0.5f / NREP(8), rep == 0 ? first : 0};
            pg8::gemm_phase<EpiResid, pg8::DnOrder, true, true>(lds, g, S, E);
            pg8::DnHalfOrder Sh; Sh.init(DFF, bx);
            EpiResidT<1> Eh{a.in[0], a.in[1], X, MODV + (size_t)l * 5 * 18432 + (size_t)(half ? 8 : 2) * DM, 0.5f / NREP(8), rep == 0 ? first : 0};
            pg8::gemm_phase<EpiResidT<1>, pg8::DnHalfOrder, true, true, 1>(lds, g, Sh, Eh); }
        SEAM();
        if (half == 0) {
            if ((PHM & 2) && RUN()) for (int rep = 0; rep < NREP(2); ++rep) phase_norm_tiled<false>(a, lds, vcu, G, l, 1);
            SEAM();
            if (l == 0) {
                if ((PHM & 16) && RUN()) for (int rep = 0; rep < NREP(16); ++rep) { pg8::Gemm g{(const bf16_t*)(ws + WS_H), (const bf16_t*)(ws + WS_WINA), MTOK, INA, DM, 1};
                    pg8::StaticOrder S; S.init(MTOK, INA, DM, G, bx, WGM_UP); S.lim = 6 * G; EpiQkvEven E{(bf16_t*)(ws + WS_U), a.out + OUT_AK, a.out + OUT_AV};
                    pg8::gemm_phase<EpiQkvEven, pg8::StaticOrder, true, true>(lds, g, S, E);
                    pg8::HalfOrder Sh; Sh.init(MTOK, INA, DM, G, bx, 6 * G, WGM_UP); EpiQkvEvenT<1> Eh{(bf16_t*)(ws + WS_U), a.out + OUT_AK, a.out + OUT_AV};
                    pg8::gemm_phase<EpiQkvEvenT<1>, pg8::HalfOrder, true, true, 1>(lds, g, Sh, Eh); }
                SEAM();
                if ((PHM & 32) && RUN()) for (int rep = 0; rep < NREP(32); ++rep) phase_mix_even(a, lds, vcu, G);
                SEAM();
            } else {
                if ((PHM & 64) && RUN()) for (int rep = 0; rep < NREP(64); ++rep) { pg8::Gemm g{(const bf16_t*)(ws + WS_H), (const bf16_t*)(ws + WS_WINC), MTOK, INC, DM, 1};
                    pg8::StaticOrder S; S.init(MTOK, INC, DM, G, bx, WGM_UP);
                    EpiQkvOdd E{(bf16_t*)(ws + WS_U), a.out + OUT_CK, a.out + OUT_CV, (const float*)(ws + WS_ROPE), (const float*)(ws + WS_ROPE) + 2048};
                    pg8::gemm_phase<EpiQkvOdd, pg8::StaticOrder, true, true>(lds, g, S, E); }
                SEAM();
                if ((PHM & 128) && RUN()) for (int rep = 0; rep < NREP(128); ++rep) phase_mix_odd(a, lds, vcu, G);
                SEAM();
            }
            if ((PHM & 512) && RUN()) for (int rep = 0; rep < NREP(512); ++rep) { pg8::Gemm g{(const bf16_t*)(ws + WS_AO), (const bf16_t*)(ws + (l == 0 ? WS_WOA : WS_WOC)), MTOK, DM, DM, 0};
                pg8::DnOrder S; S.init(DM, bx);
                EpiResid E{a.in[0], a.in[1], X, MODV + (size_t)l * 5 * 18432 + (size_t)5 * DM, 1.0f / NREP(512), 0};
                pg8::gemm_phase<EpiResid, pg8::DnOrder, true, true>(lds, g, S, E);
                pg8::DnHalfOrder Sh; Sh.init(DM, bx);
                EpiResidT<1> Eh{a.in[0], a.in[1], X, MODV + (size_t)l * 5 * 18432 + (size_t)5 * DM, 1.0f / NREP(512), 0};
                pg8::gemm_phase<EpiResidT<1>, pg8::DnHalfOrder, true, true, 1>(lds, g, Sh, Eh); }
            SEAM();
        }
    }
    if ((PHM & 1024) && RUN()) for (int rep = 0; rep < NREP(1024); ++rep) phase_final(a, vcu, G);
#undef RUN
#undef SEAM
}

extern "C" void kernel_launch(void* const* d_in, const int* in_sizes, int n_in, void* d_out, int out_size, void* d_ws, size_t ws_size, hipStream_t stream) {
    static int grid = 0;
    if (grid == 0) {
        if (n_in != 26 || ws_size < WS_END || out_size != 67108864) { fprintf(stderr, "kernel_launch: unexpected shapes: n_in %d out %d ws %zu (need %zu)\n", n_in, out_size, ws_size, (size_t)WS_END); grid = -1; return; }
        int dev = 0, cus = 0, per_cu = 0;
        if (hipGetDevice(&dev) != hipSuccess || hipDeviceGetAttribute(&cus, hipDeviceAttributeMultiprocessorCount, dev) != hipSuccess) { grid = -1; return; }
        if (hipFuncSetAttribute((const void*)mk_fwd, hipFuncAttributeMaxDynamicSharedMemorySize, LDS_BYTES) != hipSuccess) { fprintf(stderr, "kernel_launch: hipFuncSetAttribute failed\n"); grid = -1; return; }
        if (hipOccupancyMaxActiveBlocksPerMultiprocessor(&per_cu, (const void*)mk_fwd, 512, LDS_BYTES) != hipSuccess || per_cu < 1) fprintf(stderr, "kernel_launch: occupancy query says %d\n", per_cu);
        (void)hipGetLastError();
        grid = cus;
        if (cus != 256) { fprintf(stderr, "kernel_launch: built for a 256-CU device (got %d)\n", cus); grid = -1; return; }
    }
    if (grid < 0) return;
    (void)hipMemsetAsync((char*)d_ws + WS_CTL, 0, CTL_BYTES, stream);
    Args a{};
    for (int i = 0; i < 26; ++i) a.in[i] = (const float*)d_in[i];
    a.out = (float*)d_out; a.ws = (unsigned char*)d_ws;
#if MK_SPLIT
    for (int p = 0; p < N_PHASES; ++p) { a.ph_lo = p; a.ph_hi = p + 1; hipLaunchKernelGGL(mk_fwd, dim3(grid), dim3(512), LDS_BYTES, stream, a); }
#else
    a.ph_lo = 0; a.ph_hi = N_PHASES; hipLaunchKernelGGL(mk_fwd, dim3(grid), dim3(512), LDS_BYTES, stream, a);
#endif
    const hipError_t le = hipPeekAtLastError();
    if (le != hipSuccess) fprintf(stderr, "kernel_launch: launch failed: %s\n", hipGetErrorName(le));
}
```

```cpp
#include <hip/hip_runtime.h>
#include <cstdio>
#include <cstdint>

#ifndef MK_SPLIT
#define MK_SPLIT 0
#endif

#define LAS __attribute__((address_space(3)))
__device__ __forceinline__ int opq_s(int x) { asm volatile("" : "+s"(x)); return x; }
__device__ __forceinline__ int opq_v(int x) { asm volatile("" : "+v"(x)); return x; }
extern __shared__ __attribute__((aligned(16))) unsigned char mk_lds[];
constexpr int WTAB_OFF = 135168 + 256;
__device__ __forceinline__ int mk_tidx() {
    const unsigned slot = (unsigned)__builtin_amdgcn_s_getreg(((6 - 1) << 11) | 4) & 63u;
    const int w = __builtin_amdgcn_readfirstlane(((const LAS int*)(mk_lds + WTAB_OFF))[slot]);
    const int lane = (int)__builtin_amdgcn_mbcnt_hi(~0u, __builtin_amdgcn_mbcnt_lo(~0u, 0u));
    return opq_v(w * 64 + lane);
}
#define TIDX() mk_tidx()
template <int K> __device__ __forceinline__ float swz_xor(float v) { return __int_as_float(__builtin_amdgcn_ds_swizzle(__float_as_int(v), (K << 10) | 0x1f)); }
typedef unsigned short bf16_t;
typedef short bf16x8 __attribute__((ext_vector_type(8)));
typedef short s16x4 __attribute__((ext_vector_type(4)));
typedef float f32x4 __attribute__((ext_vector_type(4)));
typedef float f32x2 __attribute__((ext_vector_type(2)));
typedef float f32x16 __attribute__((ext_vector_type(16)));
typedef unsigned u32x4 __attribute__((ext_vector_type(4)));
typedef unsigned u32x2 __attribute__((ext_vector_type(2)));

constexpr int DM = 2048, NCTX = 4096, NLAT = 16384, MTOK = NCTX + NLAT, DFF = 5632, NMOD = 9;
constexpr int INA = 5120, INC = 6144;
constexpr float EPS = 1e-6f;
constexpr float LAM_INIT = 0.35550906759096926f;
constexpr float QSC = 0.12751743074602467f;

constexpr size_t MiB = (size_t)1 << 20;
constexpr size_t WS_CTL = 0, CTL_BYTES = 64 * 1024;
constexpr size_t WS_MOD = 1 * MiB;
constexpr size_t WS_ROPE = 2 * MiB;
constexpr size_t WS_CAK = 3 * MiB, WS_CAV = 7 * MiB, WS_CCK = 11 * MiB, WS_CCV = 19 * MiB;
constexpr size_t WS_W13 = 32 * MiB, W13_BYTES = 44 * MiB;
constexpr size_t WS_W2 = 208 * MiB, W2_BYTES = 22 * MiB;
constexpr size_t WS_WINA = 296 * MiB, WS_WINC = 316 * MiB, WS_WOA = 340 * MiB, WS_WOC = 348 * MiB;
constexpr int XS = 2176;
constexpr size_t WS_X = 356 * MiB;
constexpr size_t WS_H = 522 * MiB;
constexpr size_t WS_U = 676 * MiB;
constexpr size_t WS_AO = 916 * MiB;
constexpr size_t WS_END = 996 * MiB;
constexpr int CW_BAR = 1024;

constexpr size_t OUT_Y = 0, OUT_AK = (size_t)MTOK * DM, OUT_AV = OUT_AK + 4194304, OUT_CK = OUT_AV + 4194304, OUT_CV = OUT_CK + 8388608;

constexpr int LDS_BYTES = 147456;
constexpr int MISC_OFF = 135168;

namespace pg8 {
constexpr int BM = 256, BK = 64, HALF = 128, HTB = HALF * BK * 2, STAGE_BYTES = 8 * HTB, NXCD = 8, WGM = 4;
#ifndef WGM_UP
#define WGM_UP 8
#endif
#ifndef WGM_DN
#define WGM_DN 4
#endif
__host__ __device__ __forceinline__ int lds_byte(int r, int c) { const int st = (r >> 4) * 2 + (c >> 5), rr = r & 15, cc = c & 31, ob = rr * 64 + cc * 2; return st * 1024 + (ob ^ (((ob >> 9) & 1) << 5)); }
__host__ __device__ __forceinline__ void stage_rc(int b, int& R, int& C) { const int st = b / 1024, sb = b % 1024, swz = sb ^ (((sb >> 9) & 1) << 5); R = (st >> 1) * 16 + swz / 64; C = (st & 1) * 32 + (swz % 64) / 2; }
__host__ __device__ __forceinline__ int perm32(int rho) { const int n = rho >> 4, i = rho & 15; return 8 * (i >> 2) + 4 * n + (i & 3); }
struct Unit { int pm, pn, kt0, nkt, part; };
struct Gemm { const bf16_t* A; const bf16_t* Bt; int M, N, K; int atiled; };
struct StaticOrder {
    int nM, nN, nwg, G, c, nt, lim, wgm;
    __device__ void init(int M, int N, int K, int G_, int c_, int wgm_ = WGM) { nM = M / BM; nN = N / BM; nwg = nM * nN; G = G_; c = c_; nt = K / BK; lim = nwg; wgm = wgm_; }
    __device__ bool next(int i, Unit& u) const {
        const long L = (long)i * G + c; if (L >= lim) return false;
        int wgid = (int)L; { const int q = nwg / NXCD, r = nwg % NXCD, xcd = wgid % NXCD, off = wgid / NXCD; wgid = (xcd < r ? xcd * (q + 1) : r * (q + 1) + (xcd - r) * q) + off; }
        const int nig = wgm * nN, gid = wgid / nig, fm = gid * wgm, gsz = (nM - fm) < wgm ? (nM - fm) : wgm;
        u.pm = fm + ((wgid % nig) % gsz); u.pn = (wgid % nig) / gsz; u.kt0 = 0; u.nkt = nt; u.part = 0; return true;
    }
    __device__ __forceinline__ void a_ready(const Unit&) const {}
    __device__ __forceinline__ void done(const Unit&) const {}
};
struct HalfOrder {
    int nM, nN, nwg, G, c, nt, base, wgm;
    __device__ void init(int M, int N, int K, int G_, int c_, int base_, int wgm_ = WGM) { nM = M / BM; nN = N / BM; nwg = nM * nN; G = G_; c = c_; nt = K / BK; base = base_; wgm = wgm_; }
    __device__ bool next(int i, Unit& u) const {
        if (i > 0) return false;
        const int x = c % NXCD, y = c / NXCD, L = base + x + NXCD * (y >> 1); if (L >= nwg) return false;
        int wgid = L; { const int q = nwg / NXCD, r = nwg % NXCD, xcd = wgid % NXCD, off = wgid / NXCD; wgid = (xcd < r ? xcd * (q + 1) : r * (q + 1) + (xcd - r) * q) + off; }
        const int nig = wgm * nN, gid = wgid / nig, fm = gid * wgm, gsz = (nM - fm) < wgm ? (nM - fm) : wgm;
        u.pm = fm + ((wgid % nig) % gsz); u.pn = (wgid % nig) / gsz; u.kt0 = 0; u.nkt = nt; u.part = y & 1; return true;
    }
    __device__ __forceinline__ void a_ready(const Unit&) const {}
    __device__ __forceinline__ void done(const Unit&) const {}
};
struct DnOrder {
    int c, nt;
    __device__ void init(int K, int c_) { c = c_; nt = K / BK; }
    __device__ bool next(int i, Unit& u) const {
        if (i >= 2) return false;
        const int xcd = c % NXCD, slot = c / NXCD, grp = i * NXCD + xcd;
        u.pm = 4 * grp + (slot & 3); u.pn = slot >> 2; u.kt0 = 0; u.nkt = nt; u.part = 0; return true;
    }
    __device__ __forceinline__ void a_ready(const Unit&) const {}
    __device__ __forceinline__ void done(const Unit&) const {}
};
struct DnHalfOrder {
    int c, nt;
    __device__ void init(int K, int c_) { c = c_; nt = K / BK; }
    __device__ bool next(int i, Unit& u) const {
        if (i > 0) return false;
        const int x = c % NXCD, y = c / NXCD, grp = 16 + (x >> 1), w = (x & 1) * 16 + (y >> 1);
        u.pm = 4 * grp + (w & 3); u.pn = w >> 2; u.kt0 = 0; u.nkt = nt; u.part = y & 1; return true;
    }
    __device__ __forceinline__ void a_ready(const Unit&) const {}
    __device__ __forceinline__ void done(const Unit&) const {}
};
__device__ __forceinline__ unsigned cvt_pk_bf16(float lo, float hi) { unsigned r; asm volatile("v_cvt_pk_bf16_f32 %0, %1, %2" : "=v"(r) : "v"(lo), "v"(hi)); return r; }

template <class Epi, class Sched, bool ALIGN_EPI = false, bool SP2 = false, int NB = 2>
__device__ __forceinline__ void gemm_phase(LAS unsigned char* lds, const Gemm g, const Sched& S, const Epi& E) {
    const int tid = TIDX(), wid = __builtin_amdgcn_readfirstlane(tid >> 6), lane = tid & 63, wr = wid >> 2, wc = wid & 3, fr = lane & 15, fq = lane >> 4;
    const int K = g.K;
    unsigned voffA[2], voffB[2];
#pragma unroll
    for (int i = 0; i < 2; ++i) { int R, C; stage_rc(tid * 16 + i * 8192, R, C); const int Rb = Epi::PERM ? ((R & ~31) + perm32(R & 31)) : R;
        voffA[i] = g.atiled ? (unsigned)(tid * 16 + i * 8192) : (unsigned)(R * K + C) * 2u; (void)Rb; voffB[i] = (unsigned)(tid * 16 + i * 8192); }
    const size_t kstep = g.atiled ? (size_t)(2 * HTB) : (size_t)(BK * 2);
    const size_t hstep = g.atiled ? (size_t)HTB : (size_t)HALF * K * 2;
    const size_t tstep = g.atiled ? (size_t)(K / BK) * (size_t)(2 * HTB) : 2 * (size_t)HALF * K * 2;
    const size_t kstepB = (size_t)(2 * HTB), hstepB = (size_t)HTB, tstepB = (size_t)(K / BK) * kstepB;
    const size_t bh = (NB == 2) ? hstepB : 0;
    static_assert(SP2, "the tiled B image is wired into the SP2 schedule only");
    const unsigned ldsw = (unsigned)wid * 1024u;
    const int aoff = lds_byte(wr * 64 + fr, fq * 8), boff = lds_byte(wc * 32 + fr, fq * 8);
#define PG8_SA(b, h) (((b) * 2 + (h)) * HTB)
#define PG8_SB(b, h) ((4 + (b) * 2 + (h)) * HTB)
#define PG8_STAGE(bufoff, gbase, voff) do { _Pragma("unroll") for (int _i = 0; _i < 2; ++_i) \
        __builtin_amdgcn_global_load_lds((const unsigned*)((const char*)(gbase) + (voff)[_i]), (LAS unsigned*)(lds + (bufoff) + ldsw + _i * 8192), 16, 0, 0); } while (0)
#define PG8_LDA(dst, b, h) do { _Pragma("unroll") for (int m = 0; m < 4; ++m) _Pragma("unroll") for (int k = 0; k < 2; ++k) dst[m][k] = *(const LAS bf16x8*)(lds + PG8_SA(b, h) + aoff + m * 2048 + k * 1024); } while (0)
#define PG8_LDB(dst, b, h) do { _Pragma("unroll") for (int n = 0; n < 2; ++n) _Pragma("unroll") for (int k = 0; k < 2; ++k) dst[n][k] = *(const LAS bf16x8*)(lds + PG8_SB(b, h) + boff + n * 2048 + k * 1024); } while (0)
#define PG8_MMA(ai, bj, At, Bt) do { __builtin_amdgcn_s_setprio(3); _Pragma("unroll") for (int m = 0; m < 4; ++m) _Pragma("unroll") for (int n = 0; n < 2; ++n) _Pragma("unroll") for (int k = 0; k < 2; ++k) \
        acc[ai][bj][m][n] = __builtin_amdgcn_mfma_f32_16x16x32_bf16(Bt[n][k], At[m][k], acc[ai][bj][m][n], 0, 0, 0); __builtin_amdgcn_s_setprio(0); } while (0)
#define PG8_WAIT_V(n) asm volatile("s_waitcnt vmcnt(" #n ")" ::: "memory")
#define PG8_WAIT_L(n) asm volatile("s_waitcnt lgkmcnt(" #n ")" ::: "memory")
#define PG8_BAR __builtin_amdgcn_s_barrier()
#define PG8_SCHED __builtin_amdgcn_sched_barrier(0)
    Unit cur, nxt; int ui = 0;
    if (!S.next(0, cur)) return;
    f32x4 acc[2][2][4][2];
#pragma unroll
    for (int a = 0; a < 2; ++a)
#pragma unroll
        for (int b = 0; b < 2; ++b)
#pragma unroll
            for (int m = 0; m < 4; ++m)
#pragma unroll
                for (int n = 0; n < 2; ++n) acc[a][b][m][n] = (f32x4){0.f, 0.f, 0.f, 0.f};
    bf16x8 At[4][2], B0[2][2], B1[2][2];
    const char* cA = (const char*)g.A + (size_t)cur.pm * tstep + (size_t)cur.kt0 * kstep; const char* cB = (const char*)g.Bt + (size_t)cur.pn * tstepB + (NB == 1 ? (size_t)cur.part * hstepB : 0) + (size_t)cur.kt0 * kstepB;
    S.a_ready(cur);
    if constexpr (SP2) {
        PG8_STAGE(PG8_SB(0, 0), cB, voffB); PG8_STAGE(PG8_SB(0, 1), cB + bh, voffB); PG8_STAGE(PG8_SA(0, 0), cA, voffA); PG8_STAGE(PG8_SA(0, 1), cA + hstep, voffA);
        if (wr == 1) PG8_BAR;
        PG8_WAIT_V(2); PG8_BAR;
        PG8_STAGE(PG8_SB(1, 0), cB + kstepB, voffB); PG8_STAGE(PG8_SA(1, 0), cA + kstep, voffA); PG8_STAGE(PG8_SB(1, 1), cB + bh + kstepB, voffB);
        PG8_WAIT_V(6); PG8_BAR;
    } else {
        PG8_STAGE(PG8_SB(0, 0), cB, voffB); PG8_STAGE(PG8_SA(0, 0), cA, voffA); PG8_STAGE(PG8_SB(0, 1), cB + hstep, voffB); PG8_STAGE(PG8_SA(0, 1), cA + hstep, voffA);
        if (wr == 1) PG8_BAR;
        PG8_WAIT_V(4); PG8_BAR;
        PG8_STAGE(PG8_SB(1, 0), cB + kstep, voffB); PG8_STAGE(PG8_SA(1, 0), cA + kstep, voffA); PG8_STAGE(PG8_SB(1, 1), cB + hstep + kstep, voffB);
        PG8_WAIT_V(6); PG8_BAR;
    }
    for (;;) {
        const bool has_next = S.next(ui + 1, nxt);
        const char* nA = has_next ? (const char*)g.A + (size_t)nxt.pm * tstep + (size_t)nxt.kt0 * kstep : cA; const char* nB = has_next ? (const char*)g.Bt + (size_t)nxt.pn * tstepB + (NB == 1 ? (size_t)nxt.part * hstepB : 0) + (size_t)nxt.kt0 * kstepB : cB;
        const int nt = cur.nkt;
        for (int t = 0; t < nt; t += 2) {
            const bool last = (t == nt - 2);
            const char* a1 = cA + (size_t)(t + 1) * kstep;
            const char* a2 = last ? nA : cA + (size_t)(t + 2) * kstep; const char* b2 = last ? nB : cB + (size_t)(t + 2) * kstepB;
            const char* a3 = a2 + kstep; const char* b3 = b2 + kstepB;
            if (last && has_next) S.a_ready(nxt);
            if constexpr (SP2) {
            PG8_LDB(B0, 0, 0); if constexpr (NB == 2) PG8_LDB(B1, 0, 1); PG8_SCHED; PG8_LDA(At, 0, 0); PG8_STAGE(PG8_SA(1, 1), a1 + hstep, voffA);
            PG8_WAIT_V(8); PG8_WAIT_L(0); PG8_BAR; PG8_MMA(0, 0, At, B0); if constexpr (NB == 2) PG8_MMA(0, 1, At, B1); PG8_BAR; PG8_SCHED;
            PG8_LDA(At, 0, 1); PG8_STAGE(PG8_SB(0, 0), b2, voffB); PG8_STAGE(PG8_SB(0, 1), b2 + bh, voffB); PG8_STAGE(PG8_SA(0, 0), a2, voffA);
            PG8_WAIT_V(8); PG8_WAIT_L(0); PG8_BAR; PG8_MMA(1, 0, At, B0); if constexpr (NB == 2) PG8_MMA(1, 1, At, B1); PG8_BAR; PG8_SCHED;
            PG8_LDB(B0, 1, 0); if constexpr (NB == 2) PG8_LDB(B1, 1, 1); PG8_SCHED; PG8_LDA(At, 1, 0); PG8_STAGE(PG8_SA(0, 1), a2 + hstep, voffA);
            PG8_WAIT_V(8); PG8_WAIT_L(0); PG8_BAR; PG8_MMA(0, 0, At, B0); if constexpr (NB == 2) PG8_MMA(0, 1, At, B1); PG8_BAR; PG8_SCHED;
            PG8_LDA(At, 1, 1); PG8_STAGE(PG8_SB(1, 0), b3, voffB); PG8_STAGE(PG8_SB(1, 1), b3 + bh, voffB); PG8_STAGE(PG8_SA(1, 0), a3, voffA);
            PG8_WAIT_V(8); PG8_WAIT_L(0); PG8_BAR; PG8_MMA(1, 0, At, B0); if constexpr (NB == 2) PG8_MMA(1, 1, At, B1); PG8_BAR; PG8_SCHED;
            } else {
            PG8_LDB(B0, 0, 0); PG8_SCHED; PG8_LDA(At, 0, 0); PG8_STAGE(PG8_SA(1, 1), a1 + hstep, voffA);
            PG8_WAIT_L(8); PG8_BAR; PG8_WAIT_L(0); PG8_MMA(0, 0, At, B0); PG8_BAR; PG8_SCHED;
            PG8_LDB(B1, 0, 1); PG8_STAGE(PG8_SB(0, 0), b2, voffB);
            PG8_BAR; PG8_WAIT_L(0); PG8_MMA(0, 1, At, B1); PG8_BAR;
            PG8_LDA(At, 0, 1); PG8_STAGE(PG8_SA(0, 0), a2, voffA);
            PG8_BAR; PG8_WAIT_L(0); PG8_MMA(1, 0, At, B0); PG8_BAR; PG8_SCHED;
            PG8_STAGE(PG8_SB(0, 1), b2 + hstep, voffB);
            PG8_WAIT_V(6); PG8_BAR; PG8_MMA(1, 1, At, B1); PG8_BAR;
            PG8_LDB(B0, 1, 0); PG8_SCHED; PG8_LDA(At, 1, 0); PG8_STAGE(PG8_SA(0, 1), a2 + hstep, voffA);
            PG8_WAIT_L(8); PG8_BAR; PG8_WAIT_L(0); PG8_MMA(0, 0, At, B0); PG8_BAR; PG8_SCHED;
            PG8_LDB(B1, 1, 1); PG8_STAGE(PG8_SB(1, 0), b3, voffB);
            PG8_BAR; PG8_WAIT_L(0); PG8_MMA(0, 1, At, B1); PG8_BAR;
            PG8_LDA(At, 1, 1); PG8_STAGE(PG8_SA(1, 0), a3, voffA);
            PG8_BAR; PG8_WAIT_L(0); PG8_MMA(1, 0, At, B0); PG8_BAR; PG8_SCHED;
            PG8_STAGE(PG8_SB(1, 1), b3 + hstep, voffB);
            PG8_WAIT_V(6); PG8_BAR; PG8_MMA(1, 1, At, B1); PG8_BAR;
            }
        }
        if constexpr (ALIGN_EPI) { if (wr == 0) PG8_BAR; }
        E(acc, cur, wr, wc, fr, fq); S.done(cur);
        if (!has_next) break;
#pragma unroll
        for (int a = 0; a < 2; ++a)
#pragma unroll
            for (int b = 0; b < 2; ++b)
#pragma unroll
                for (int m = 0; m < 4; ++m)
#pragma unroll
                    for (int n = 0; n < 2; ++n) acc[a][b][m][n] = (f32x4){0.f, 0.f, 0.f, 0.f};
        cur = nxt; cA = nA; cB = nB; ++ui;
        if constexpr (ALIGN_EPI) { if (wr == 1) PG8_BAR; }
    }
    PG8_WAIT_V(0);
    if constexpr (!ALIGN_EPI) { if (wr == 0) PG8_BAR; }
    PG8_BAR;
#undef PG8_SA
#undef PG8_SB
#undef PG8_STAGE
#undef PG8_LDA
#undef PG8_LDB
#undef PG8_MMA
#undef PG8_WAIT_V
#undef PG8_WAIT_L
#undef PG8_BAR
#undef PG8_SCHED
}
}

__device__ __forceinline__ float silu_mul(float a, float b) { const float e = __builtin_amdgcn_exp2f(-1.4426950408889634f * a); return a * __builtin_amdgcn_rcpf(1.0f + e) * b; }
__device__ __forceinline__ int mod_index(int pm) { return pm < 16 ? 0 : 1 + ((pm - 16) >> 4); }

__device__ __forceinline__ void unpack8(const u32x4 w, f32x4& a, f32x4& b) {
    a = (f32x4){__uint_as_float(w.x << 16), __uint_as_float(w.x & 0xffff0000u), __uint_as_float(w.y << 16), __uint_as_float(w.y & 0xffff0000u)};
    b = (f32x4){__uint_as_float(w.z << 16), __uint_as_float(w.z & 0xffff0000u), __uint_as_float(w.w << 16), __uint_as_float(w.w & 0xffff0000u)};
}
__device__ __forceinline__ u32x4 pack8(const f32x4 a, const f32x4 b) {
    u32x4 w; w.x = pg8::cvt_pk_bf16(a[0], a[1]); w.y = pg8::cvt_pk_bf16(a[2], a[3]); w.z = pg8::cvt_pk_bf16(b[0], b[1]); w.w = pg8::cvt_pk_bf16(b[2], b[3]); return w;
}
struct EpiSwiglu {
    static constexpr bool PERM = true;
    bf16_t* U;
    __device__ __forceinline__ void operator()(const f32x4 (&acc)[2][2][4][2], const pg8::Unit& u, int wr, int wc, int fr_, int fq_) const {
        const int fr = opq_v(fr_), fq = opq_v(fq_);
        const int row0 = u.pm * 256 + wr * 64 + fr, col0 = u.pn * 128 + wc * 32 + 8 * fq;
#pragma unroll
        for (int ai = 0; ai < 2; ++ai)
#pragma unroll
            for (int m = 0; m < 4; ++m) {
                bf16_t* rowp = (bf16_t*)((char*)U + (((size_t)u.pm * (DFF / 64) + (u.pn * 2 + (wc >> 1))) * 2 + ai) * 16384 + pg8::lds_byte(wr * 64 + m * 16 + fr, (wc & 1) * 32 + 8 * fq));
                const f32x4 a0 = acc[ai][0][m][0], a1 = acc[ai][0][m][1], b0 = acc[ai][1][m][0], b1 = acc[ai][1][m][1];
                u32x4 w;
                w.x = pg8::cvt_pk_bf16(silu_mul(a0[0], b0[0]), silu_mul(a0[1], b0[1])); w.y = pg8::cvt_pk_bf16(silu_mul(a0[2], b0[2]), silu_mul(a0[3], b0[3]));
                w.z = pg8::cvt_pk_bf16(silu_mul(a1[0], b1[0]), silu_mul(a1[1], b1[1])); w.w = pg8::cvt_pk_bf16(silu_mul(a1[2], b1[2]), silu_mul(a1[3], b1[3]));
                *(u32x4*)rowp = w;
            }
    }
};
template <int NB> struct EpiResidT {
    static constexpr bool PERM = true;
    const float* xp; const float* xs; bf16_t* X; const float* gate; float coef; int first;
    __device__ __forceinline__ void operator()(const f32x4 (&acc)[2][2][4][2], const pg8::Unit& u, int wr, int wc, int fr_, int fq_) const {
        const int fr = opq_v(fr_), fq = opq_v(fq_);
        const int row0 = wr * 64 + fr, col0 = u.pn * 256 + (NB == 1 ? u.part * 128 : 0) + wc * 32 + 8 * fq;
        const float* basef = u.pm < 16 ? xp + (size_t)u.pm * 256 * DM : xs + (size_t)(u.pm - 16) * 256 * DM;
        bf16_t* xb = X + (size_t)u.pm * 256 * XS;
        const float* g = gate + (size_t)mod_index(u.pm) * NMOD * DM + col0;
        f32x4 gv[NB][2];
#pragma unroll
        for (int bj = 0; bj < NB; ++bj)
#pragma unroll
            for (int n = 0; n < 2; ++n) gv[bj][n] = *(const f32x4*)(g + bj * 128 + n * 4) * coef;
#pragma unroll
        for (int ai = 0; ai < 2; ++ai)
#pragma unroll
            for (int m = 0; m < 4; ++m) { const int r = row0 + ai * 128 + m * 16;
#pragma unroll
                for (int bj = 0; bj < NB; ++bj) { f32x4 b0, b1;
                    if (first) { const float* bp = basef + (size_t)r * DM + col0 + bj * 128; b0 = *(const f32x4*)bp; b1 = *(const f32x4*)(bp + 4); }
                    else unpack8(*(const u32x4*)(xb + (size_t)r * XS + col0 + bj * 128), b0, b1);
                    *(u32x4*)(xb + (size_t)r * XS + col0 + bj * 128) = pack8(b0 + gv[bj][0] * acc[ai][bj][m][0], b1 + gv[bj][1] * acc[ai][bj][m][1]); } }
    }
};
using EpiResid = EpiResidT<2>;
template <int NB> struct EpiQkvEvenT {
    static constexpr bool PERM = true;
    bf16_t* QKV; float* out_k; float* out_v;
    __device__ __forceinline__ void operator()(const f32x4 (&acc)[2][2][4][2], const pg8::Unit& u, int wr, int wc, int fr_, int fq_) const {
        const int fr = opq_v(fr_), fq = opq_v(fq_);
        const int rowt = wr * 64 + fr, colt = (NB == 1 ? u.part * 128 : 0) + wc * 32 + 8 * fq;
        const bool ctx = u.pm < 16; const int seg = u.pn >> 2;
        float* of = (seg == 1) ? out_k : out_v; const bool wf = ctx && (seg == 1 || seg == 2); const float qs = (seg == 0) ? QSC : 1.0f;
#pragma unroll
        for (int ai = 0; ai < 2; ++ai)
#pragma unroll
            for (int m = 0; m < 4; ++m) { const int r = rowt + ai * 128 + m * 16;
                bf16_t* rowp = QKV + (size_t)(u.pm * 256 + r) * INA + u.pn * 256 + colt;
#pragma unroll
                for (int bj = 0; bj < NB; ++bj) { const f32x4 v0 = acc[ai][bj][m][0], v1 = acc[ai][bj][m][1]; const f32x4 s0 = v0 * qs, s1 = v1 * qs;
                    u32x4 w; w.x = pg8::cvt_pk_bf16(s0[0], s0[1]); w.y = pg8::cvt_pk_bf16(s0[2], s0[3]); w.z = pg8::cvt_pk_bf16(s1[0], s1[1]); w.w = pg8::cvt_pk_bf16(s1[2], s1[3]);
                    *(u32x4*)(rowp + bj * 128) = w;
                    if (wf) { const int h = (u.pn & 3) * 2 + bj + (NB == 1 ? u.part : 0);
                        float* op = of + ((size_t)(u.pm * 8 + h) * 256 + r) * 128 + wc * 32 + 8 * fq; *(f32x4*)op = v0; *(f32x4*)(op + 4) = v1; } } }
    }
};
using EpiQkvEven = EpiQkvEvenT<2>;
struct EpiQkvOdd {
    static constexpr bool PERM = true;
    bf16_t* QKV; float* out_k; float* out_v; const float* rcos; const float* rsin;
    __device__ __forceinline__ void operator()(const f32x4 (&acc)[2][2][4][2], const pg8::Unit& u, int wr, int wc, int fr_, int fq_) const {
        const int fr = opq_v(fr_), fq = opq_v(fq_);
        const int rowt = wr * 64 + fr; const bool ctx = u.pm < 16;
        if (u.pn < 16) {
            const int isk = u.pn >> 3, head = 2 * (u.pn & 7) + (wc >> 1), part = wc & 1, i0 = 8 * fq;
            const int colb = isk * 2048 + head * 128 + part * 64 + i0;
#pragma unroll
            for (int ai = 0; ai < 2; ++ai)
#pragma unroll
                for (int m = 0; m < 4; ++m) { const int r = rowt + ai * 128 + m * 16;
                    f32x4 x1a = acc[ai][0][m][0], x1b = acc[ai][0][m][1], x2a = acc[ai][1][m][0], x2b = acc[ai][1][m][1];
                    if (!ctx) { const int t = ((u.pm - 16) & 15) * 256 + r; const int pos = part ? (t & 63) : (t >> 6);
                        const f32x4 ca = *(const f32x4*)(rcos + pos * 32 + i0), cb = *(const f32x4*)(rcos + pos * 32 + i0 + 4), sa = *(const f32x4*)(rsin + pos * 32 + i0), sb = *(const f32x4*)(rsin + pos * 32 + i0 + 4);
                        const f32x4 o1a = x1a * ca - x2a * sa, o1b = x1b * cb - x2b * sb, o2a = x2a * ca + x1a * sa, o2b = x2b * cb + x1b * sb;
                        x1a = o1a; x1b = o1b; x2a = o2a; x2b = o2b; }
                    if (!isk) { x1a *= QSC; x1b *= QSC; x2a *= QSC; x2b *= QSC; }
                    bf16_t* rowp = QKV + (size_t)(u.pm * 256 + r) * INC + colb;
                    u32x4 w; w.x = pg8::cvt_pk_bf16(x1a[0], x1a[1]); w.y = pg8::cvt_pk_bf16(x1a[2], x1a[3]); w.z = pg8::cvt_pk_bf16(x1b[0], x1b[1]); w.w = pg8::cvt_pk_bf16(x1b[2], x1b[3]);
                    *(u32x4*)rowp = w;
                    w.x = pg8::cvt_pk_bf16(x2a[0], x2a[1]); w.y = pg8::cvt_pk_bf16(x2a[2], x2a[3]); w.z = pg8::cvt_pk_bf16(x2b[0], x2b[1]); w.w = pg8::cvt_pk_bf16(x2b[2], x2b[3]);
                    *(u32x4*)(rowp + 32) = w;
                    if (ctx && isk) { float* op = out_k + ((size_t)(u.pm * 16 + head) * 256 + r) * 128 + part * 64 + i0;
                        *(f32x4*)op = x1a; *(f32x4*)(op + 4) = x1b; *(f32x4*)(op + 32) = x2a; *(f32x4*)(op + 36) = x2b; }
                }
        } else {
            const int colt = wc * 32 + 8 * fq, h = u.pn - 16;
#pragma unroll
            for (int ai = 0; ai < 2; ++ai)
#pragma unroll
                for (int m = 0; m < 4; ++m) { const int r = rowt + ai * 128 + m * 16;
                    bf16_t* rowp = QKV + (size_t)(u.pm * 256 + r) * INC + u.pn * 256 + colt;
#pragma unroll
                    for (int bj = 0; bj < 2; ++bj) { const f32x4 v0 = acc[ai][bj][m][0], v1 = acc[ai][bj][m][1];
                        u32x4 w; w.x = pg8::cvt_pk_bf16(v0[0], v0[1]); w.y = pg8::cvt_pk_bf16(v0[2], v0[3]); w.z = pg8::cvt_pk_bf16(v1[0], v1[1]); w.w = pg8::cvt_pk_bf16(v1[2], v1[3]);
                        *(u32x4*)(rowp + bj * 128) = w;
                        if (ctx) { float* op = out_v + ((size_t)(u.pm * 8 + h) * 256 + r) * 256 + bj * 128 + colt; *(f32x4*)op = v0; *(f32x4*)(op + 4) = v1; } } }
        }
    }
};

namespace att {
constexpr int SHM_V = 64 * 128 * 2, SHM_K = 64 * 128 * 2;
constexpr float THRL = 11.541560327111707f, NEG = -1e30f;
constexpr int LDS_WS = 2 * SHM_V + 2 * SHM_K, LDS_TB = LDS_WS + 8 * 64 * 4;
#define KSWZ(row, colB) ((row) * 256 + ((colB) ^ (((row) & 7) << 4)))
#define SBAR() __builtin_amdgcn_sched_barrier(0)
__device__ __forceinline__ int crow(int r, int hi) { return (r & 3) + 8 * (r >> 2) + 4 * hi; }
__device__ __forceinline__ unsigned cvtpk(float lo, float hi) { unsigned r; asm volatile("v_cvt_pk_bf16_f32 %0, %1, %2" : "=v"(r) : "v"(lo), "v"(hi)); return r; }
__device__ __forceinline__ void partialSM(f32x16& p0, f32x16& p1, float& m_reg, float& mn, float& alpha, float l_reg) {
  float pmax = p0[0];
#pragma unroll
  for (int r = 1; r < 16; ++r) pmax = fmaxf(pmax, p0[r]);
#pragma unroll
  for (int r = 0; r < 16; ++r) pmax = fmaxf(pmax, p1[r]);
  { auto rr = __builtin_amdgcn_permlane32_swap(__float_as_uint(pmax), __float_as_uint(pmax), false, false);
    pmax = fmaxf(__uint_as_float(rr[0]), __uint_as_float(rr[1])); }
  const float dm = pmax - m_reg;
  if (__builtin_expect(__all(dm <= THRL && !(l_reg == 0.f && dm < -THRL)), 1)) { mn = m_reg; alpha = 1.f; }
  else { const bool fresh = (l_reg == 0.f); mn = fresh ? (fabsf(dm) > THRL ? pmax : m_reg) : fmaxf(m_reg, pmax); alpha = fresh ? 1.f : __builtin_amdgcn_exp2f(m_reg - mn); m_reg = mn; }
  if (!__builtin_expect(__all(mn == 0.f), 1)) {
#pragma unroll
    for (int r = 0; r < 16; ++r) { p0[r] -= mn; p1[r] -= mn; }
  }
#pragma unroll
  for (int r = 0; r < 16; ++r) p0[r] = __builtin_amdgcn_exp2f(p0[r]);
}
__device__ __forceinline__ void finishSM(f32x16& p0, f32x16& p1, float alpha, float& l_reg, bf16x8& pa0, bf16x8& pa1, bf16x8& pa2, bf16x8& pa3) {
#pragma unroll
  for (int r = 0; r < 16; ++r) p1[r] = __builtin_amdgcn_exp2f(p1[r]);
  float ps = 0;
#pragma unroll
  for (int r = 0; r < 16; ++r) ps += p0[r];
#pragma unroll
  for (int r = 0; r < 16; ++r) ps += p1[r];
  { auto rr = __builtin_amdgcn_permlane32_swap(__float_as_uint(ps), __float_as_uint(ps), false, false);
    ps = __uint_as_float(rr[0]) + __uint_as_float(rr[1]); }
  l_reg = l_reg * alpha + ps;
#define PK4(P, BASE, OUT) do { u32x4 w = {cvtpk(P[BASE + 0], P[BASE + 1]), cvtpk(P[BASE + 2], P[BASE + 3]), cvtpk(P[BASE + 4], P[BASE + 5]), cvtpk(P[BASE + 6], P[BASE + 7])}; \
    OUT = *reinterpret_cast<bf16x8*>(&w); } while (0)
  PK4(p0, 0, pa0); PK4(p0, 8, pa1); PK4(p1, 0, pa2); PK4(p1, 8, pa3);
#undef PK4
}
__device__ __forceinline__ void qkt(f32x16& p0, f32x16& p1, const LAS char* Ks, const bf16x8* qr, int r32, int hi) {
  p0 = f32x16{}; p1 = f32x16{};
#pragma unroll
  for (int d0 = 0; d0 < 8; ++d0) { const int cb = (d0 * 16 + hi * 8) * 2;
    const bf16x8 b0 = *(const LAS bf16x8*)(Ks + KSWZ(r32, cb));
    const bf16x8 b1 = *(const LAS bf16x8*)(Ks + KSWZ(32 + r32, cb));
    p0 = __builtin_amdgcn_mfma_f32_32x32x16_bf16(b0, qr[d0], p0, 0, 0, 0);
    p1 = __builtin_amdgcn_mfma_f32_32x32x16_bf16(b1, qr[d0], p1, 0, 0, 0); }
}
__device__ __forceinline__ int v_st(int k, int c) { const int kk = k;     return ((kk >> 3) * 4 + (c >> 5)) * 512 + ((kk & 7) * 32 + (c & 31)) * 2; }
__device__ __forceinline__ int v_rd_base(int lane) { return ((lane & 3) << 3) | (((lane >> 2) & 3) << 6) | (((lane >> 4) & 1) << 5) | (((lane >> 5) & 1) << 8); }
constexpr int v_rd_off(int d0, int ks, int half) { return d0 * 512 + ks * 4096 + half * 2048; }
template <int OFF> __device__ __forceinline__ s16x4 tr_read(int vb) {
  s16x4 r; asm volatile("ds_read_b64_tr_b16 %0, %1 offset:%2" : "=&v"(r) : "v"(vb), "i"(OFF) : "memory"); return r;
}
template <int D0> __device__ __forceinline__ void pv_one(f32x16& od, int vb, bf16x8 pa0, bf16x8 pa1, bf16x8 pa2, bf16x8 pa3) {
  const s16x4 l0 = tr_read<v_rd_off(D0, 0, 0)>(vb), h0 = tr_read<v_rd_off(D0, 0, 1)>(vb), l1 = tr_read<v_rd_off(D0, 1, 0)>(vb), h1 = tr_read<v_rd_off(D0, 1, 1)>(vb);
  const s16x4 l2 = tr_read<v_rd_off(D0, 2, 0)>(vb), h2 = tr_read<v_rd_off(D0, 2, 1)>(vb), l3 = tr_read<v_rd_off(D0, 3, 0)>(vb), h3 = tr_read<v_rd_off(D0, 3, 1)>(vb);
  asm volatile("s_waitcnt lgkmcnt(0)" ::: "memory"); SBAR();
#define PK(L, H) (bf16x8){L[0], L[1], L[2], L[3], H[0], H[1], H[2], H[3]}
  od = __builtin_amdgcn_mfma_f32_32x32x16_bf16(pa0, PK(l0, h0), od, 0, 0, 0);
  od = __builtin_amdgcn_mfma_f32_32x32x16_bf16(pa1, PK(l1, h1), od, 0, 0, 0);
  od = __builtin_amdgcn_mfma_f32_32x32x16_bf16(pa2, PK(l2, h2), od, 0, 0, 0);
  od = __builtin_amdgcn_mfma_f32_32x32x16_bf16(pa3, PK(l3, h3), od, 0, 0, 0);
#undef PK
}
__device__ __forceinline__ void pv_d0(f32x16* o, int vb, bf16x8 pa0, bf16x8 pa1, bf16x8 pa2, bf16x8 pa3) {
  pv_one<0>(o[0], vb, pa0, pa1, pa2, pa3); pv_one<1>(o[1], vb, pa0, pa1, pa2, pa3); pv_one<2>(o[2], vb, pa0, pa1, pa2, pa3); pv_one<3>(o[3], vb, pa0, pa1, pa2, pa3);
}
struct VHalf { s16x4 la, ha, lb, hb; };
template <int D0, int KS> __device__ __forceinline__ void pvh_load(VHalf& f, int vb) {
  f.la = tr_read<v_rd_off(D0, KS, 0)>(vb); f.ha = tr_read<v_rd_off(D0, KS, 1)>(vb); f.lb = tr_read<v_rd_off(D0, KS + 1, 0)>(vb); f.hb = tr_read<v_rd_off(D0, KS + 1, 1)>(vb);
}
__device__ __forceinline__ void pvh_mma(f32x16& od, const VHalf& f, bf16x8 pa, bf16x8 pb) {
#define PK(L, H) (bf16x8){L[0], L[1], L[2], L[3], H[0], H[1], H[2], H[3]}
  od = __builtin_amdgcn_mfma_f32_32x32x16_bf16(pa, PK(f.la, f.ha), od, 0, 0, 0);
  od = __builtin_amdgcn_mfma_f32_32x32x16_bf16(pb, PK(f.lb, f.hb), od, 0, 0, 0);
#undef PK
}
#define PV_WAIT4() do { asm volatile("s_waitcnt lgkmcnt(4)" ::: "memory"); SBAR(); } while (0)
#define PV_WAIT0() do { asm volatile("s_waitcnt lgkmcnt(0)" ::: "memory"); SBAR(); } while (0)
template <int NB> __device__ __forceinline__ void pv_pipe(f32x16* o, int vb, bf16x8 pa0, bf16x8 pa1, bf16x8 pa2, bf16x8 pa3) {
  VHalf fa, fb; const int vh = vb + 16384;
  pvh_load<0, 0>(fa, vb);
  pvh_load<0, 2>(fb, vb); PV_WAIT4(); pvh_mma(o[0], fa, pa0, pa1);
  pvh_load<1, 0>(fa, vb); PV_WAIT4(); pvh_mma(o[0], fb, pa2, pa3);
  pvh_load<1, 2>(fb, vb); PV_WAIT4(); pvh_mma(o[1], fa, pa0, pa1);
  pvh_load<2, 0>(fa, vb); PV_WAIT4(); pvh_mma(o[1], fb, pa2, pa3);
  pvh_load<2, 2>(fb, vb); PV_WAIT4(); pvh_mma(o[2], fa, pa0, pa1);
  pvh_load<3, 0>(fa, vb); PV_WAIT4(); pvh_mma(o[2], fb, pa2, pa3);
  pvh_load<3, 2>(fb, vb); PV_WAIT4(); pvh_mma(o[3], fa, pa0, pa1);
  if (NB == 8) {
    pvh_load<0, 0>(fa, vh); PV_WAIT4(); pvh_mma(o[3], fb, pa2, pa3);
    pvh_load<0, 2>(fb, vh); PV_WAIT4(); pvh_mma(o[4], fa, pa0, pa1);
    pvh_load<1, 0>(fa, vh); PV_WAIT4(); pvh_mma(o[4], fb, pa2, pa3);
    pvh_load<1, 2>(fb, vh); PV_WAIT4(); pvh_mma(o[5], fa, pa0, pa1);
    pvh_load<2, 0>(fa, vh); PV_WAIT4(); pvh_mma(o[5], fb, pa2, pa3);
    pvh_load<2, 2>(fb, vh); PV_WAIT4(); pvh_mma(o[6], fa, pa0, pa1);
    pvh_load<3, 0>(fa, vh); PV_WAIT4(); pvh_mma(o[6], fb, pa2, pa3);
    pvh_load<3, 2>(fb, vh); PV_WAIT4(); pvh_mma(o[7], fa, pa0, pa1);
    PV_WAIT0(); pvh_mma(o[7], fb, pa2, pa3);
  } else { PV_WAIT0(); pvh_mma(o[3], fb, pa2, pa3); }
}
struct KV { const bf16_t* k0; const bf16_t* v0; int ldk0, ldv0, nt0; const bf16_t* k1; const bf16_t* v1; int ldk1, ldv1, base1, max1; };
struct NaW { int qrow, rsq, c, cs, rsmin; const LAS float* tb; };
__device__ __forceinline__ void na_mask(f32x16& p0, f32x16& p1, int kr, const NaW& w, int hi) {
  const LAS float* tb = w.tb + (kr - w.qrow + 7) * 31 + 15 - w.c;
  const int lo = w.cs, hi_ = w.cs + 15;
#pragma unroll
  for (int r = 0; r < 16; ++r) { const int e = crow(r, hi); const int id = e < lo ? lo : (e > hi_ ? hi_ : e); const float b = tb[id]; p0[r] = (id == e) ? p0[r] + b : NEG; }
#pragma unroll
  for (int r = 0; r < 16; ++r) { const int e = 32 + crow(r, hi); const int id = e < lo ? lo : (e > hi_ ? hi_ : e); const float b = tb[id]; p1[r] = (id == e) ? p1[r] + b : NEG; }
}
template <int MODE, int SD>
__device__ __forceinline__ void attn_body(const bf16_t* __restrict__ Qb, int ldq, const KV kv, int NT, bf16_t* __restrict__ Ob, int ldo, LAS char* lds, const NaW naw) {
  const int tid = TIDX(), wid = tid >> 6, lane = tid & 63, r32 = lane & 31, hi = lane >> 5;
  LAS char* V_lds = lds; LAS char* K_lds = lds + 2 * SHM_V;
  LAS float* wsf = (LAS float*)(lds + LDS_WS) + wid * 64; LAS float* li_l = wsf; LAS float* al_l = wsf + 32;
  float m_reg = 0.f, l_reg = 0; f32x16 o[4] = {}; bf16x8 qr[8];
  const bf16_t* Qw = Qb + (size_t)(wid * 32 + r32) * ldq + hi * 8;
#pragma unroll
  for (int d0 = 0; d0 < 8; ++d0) qr[d0] = *(const bf16x8*)(Qw + d0 * 16);
  const int sr = tid >> 4, sc = (tid & 15) * 8, vst0 = v_st(sr, sc), vst1 = v_st(32 + sr, sc);
  const int vb0 = (int)(uintptr_t)V_lds + v_rd_base(lane);
  struct { bf16x8 vs0, vs1, ks0, ks1; } sr_[SD];
#define SLOAD(i, t) do { const int t_ = (t); const bf16_t* kp_; const bf16_t* vp_; int lk_, lv_; \
    if (t_ < kv.nt0) { lk_ = kv.ldk0; lv_ = kv.ldv0; kp_ = kv.k0 + (size_t)t_ * 64 * lk_; vp_ = kv.v0 + (size_t)t_ * 64 * lv_; } \
    else { int j_ = kv.base1 + (t_ - kv.nt0); j_ = j_ < kv.max1 ? j_ : kv.max1; lk_ = kv.ldk1; lv_ = kv.ldv1; kp_ = kv.k1 + (size_t)j_ * 64 * lk_; vp_ = kv.v1 + (size_t)j_ * 64 * lv_; } \
    sr_[i].vs0 = *(const bf16x8*)(vp_ + (size_t)sr * lv_ + sc); sr_[i].vs1 = *(const bf16x8*)(vp_ + (size_t)(32 + sr) * lv_ + sc); \
    sr_[i].ks0 = *(const bf16x8*)(kp_ + (size_t)sr * lk_ + sc); sr_[i].ks1 = *(const bf16x8*)(kp_ + (size_t)(32 + sr) * lk_ + sc); } while (0)
#define SWRITE(b, i) do { *(LAS bf16x8*)(V_lds + (b) * SHM_V + vst0) = sr_[i].vs0; *(LAS bf16x8*)(V_lds + (b) * SHM_V + vst1) = sr_[i].vs1; const int kc = sc * 2; \
    *(LAS bf16x8*)(K_lds + (b) * SHM_K + KSWZ(sr, kc)) = sr_[i].ks0; *(LAS bf16x8*)(K_lds + (b) * SHM_K + KSWZ(32 + sr, kc)) = sr_[i].ks1; } while (0)
#define SWAIT() do { if (SD == 2) asm volatile("s_waitcnt vmcnt(4)" ::: "memory"); else asm volatile("s_waitcnt vmcnt(0)" ::: "memory"); } while (0)
#define RESC(a) do { if (__any((a) < 1.f)) { if (hi == 0) al_l[r32] = (a); asm volatile("s_waitcnt lgkmcnt(0)" ::: "memory"); \
    _Pragma("unroll") for (int d = 0; d < 4; ++d) _Pragma("unroll") for (int r = 0; r < 16; ++r) o[d][r] *= al_l[crow(r, hi)]; } } while (0)
#define MASK(P0, P1, t) do { } while (0)
  f32x16 pA0, pA1, pB0, pB1; float mnA, mnB, alA, alB; bf16x8 pa0, pa1, pa2, pa3;
  constexpr int SE = 0, SO = SD - 1;
  SLOAD(SE, 0); asm volatile("s_waitcnt vmcnt(0)" ::: "memory"); SWRITE(0, SE); __syncthreads();
  qkt(pA0, pA1, K_lds, qr, r32, hi); MASK(pA0, pA1, 0); partialSM(pA0, pA1, m_reg, mnA, alA, l_reg);
  SLOAD(SO, 1); if (SD == 2) { if (2 < NT) SLOAD(SE, 2); }
  SWAIT(); SWRITE(1, SO); __syncthreads();
  for (int j = 1; j + 1 < NT; j += 2) {
    SBAR(); qkt(pB0, pB1, K_lds + SHM_K, qr, r32, hi); MASK(pB0, pB1, j);
    finishSM(pA0, pA1, alA, l_reg, pa0, pa1, pa2, pa3); SBAR();
    SLOAD(SO, j + SD); SBAR();
    pv_d0(o, vb0, pa0, pa1, pa2, pa3); partialSM(pB0, pB1, m_reg, mnB, alB, l_reg);
    __syncthreads(); SWAIT(); SWRITE(0, SE);
    RESC(alB); __syncthreads();
    SBAR(); qkt(pA0, pA1, K_lds, qr, r32, hi); MASK(pA0, pA1, j + 1);
    finishSM(pB0, pB1, alB, l_reg, pa0, pa1, pa2, pa3); SBAR();
    if (SD == 1 || j + 3 < NT) SLOAD(SE, j + 1 + SD); SBAR();
    pv_d0(o, vb0 + SHM_V, pa0, pa1, pa2, pa3); partialSM(pA0, pA1, m_reg, mnA, alA, l_reg);
    __syncthreads(); SWAIT(); SWRITE(1, SO);
    RESC(alA); __syncthreads();
  }
  SBAR(); qkt(pB0, pB1, K_lds + SHM_K, qr, r32, hi); MASK(pB0, pB1, NT - 1);
  finishSM(pA0, pA1, alA, l_reg, pa0, pa1, pa2, pa3); SBAR();
  pv_d0(o, vb0, pa0, pa1, pa2, pa3); partialSM(pB0, pB1, m_reg, mnB, alB, l_reg);
  __syncthreads(); RESC(alB);
  finishSM(pB0, pB1, alB, l_reg, pa0, pa1, pa2, pa3); SBAR();
  pv_d0(o, vb0 + SHM_V, pa0, pa1, pa2, pa3);
  if (hi == 0) li_l[r32] = l_reg; asm volatile("s_waitcnt lgkmcnt(0)" ::: "memory");
  float rli[16];
#pragma unroll
  for (int r = 0; r < 16; ++r) rli[r] = __builtin_amdgcn_rcpf(li_l[crow(r, hi)]);
  bf16_t* Ow = Ob + (size_t)(wid * 32) * ldo;
#pragma unroll
  for (int r = 0; r < 16; ++r) { const int orow = crow(r, hi);
#pragma unroll
    for (int d0 = 0; d0 < 4; ++d0) Ow[(size_t)orow * ldo + d0 * 32 + r32] = (bf16_t)(cvtpk(o[d0][r] * rli[r], 0.f) & 0xffffu); }
#undef SLOAD
#undef SWRITE
#undef SWAIT
#undef RESC
#undef MASK
}
struct DKV { const bf16_t* k0; const bf16_t* k1; const bf16_t* v; int ldk, ldv, nt; };
constexpr int DBUF = 65536, D_WS = 2 * DBUF;
__device__ __forceinline__ void diff_stage(LAS char* lds, int buf, const DKV& sg, int tile, int wid, int lane) {
  const int region = wid >> 1, w1 = wid & 1;
  LAS char* dst = lds + buf * DBUF + region * 16384 + w1 * 8192;
  if (region < 2) {
    const char* src = (const char*)((region ? sg.k1 : sg.k0) + ((size_t)tile * 64 + w1 * 32) * sg.ldk);
    const int rl = lane >> 4, cp = lane & 15;
    const unsigned ve = (unsigned)(rl * sg.ldk) * 2u + (unsigned)((cp ^ rl) * 16), vo = (unsigned)(rl * sg.ldk) * 2u + (unsigned)((cp ^ (rl + 4)) * 16);
#pragma unroll
    for (int i = 0; i < 8; ++i) { const char* p = src + (size_t)(4 * i) * sg.ldk * 2;
      __builtin_amdgcn_global_load_lds((const unsigned*)(p + ((i & 1) ? vo : ve)), (LAS unsigned*)(dst + i * 1024), 16, 0, 0); }
  } else {
    const char* src = (const char*)(sg.v + (size_t)tile * 64 * sg.ldv + (region - 2) * 128);
    const int q3 = (lane & 31) >> 2;
    const unsigned vl = (unsigned)((q3 * sg.ldv + (lane >> 5) * 32 + (lane & 3) * 8) * 2);
#pragma unroll
    for (int i = 0; i < 8; ++i) { const int ku = (w1 * 4 + (i >> 1)) * 8;
      const char* p = src + ((size_t)ku * sg.ldv + (i & 1) * 64) * 2;
      __builtin_amdgcn_global_load_lds((const unsigned*)(p + vl), (LAS unsigned*)(dst + i * 1024), 16, 0, 0); }
  }
}
__device__ __forceinline__ void attn_diff_body(const bf16_t* __restrict__ Q0, int ldq, const DKV sa, const DKV sb, bf16_t* __restrict__ Ob, int ldo, LAS char* lds, float lam, const float* __restrict__ gvec) {
  const int tid = TIDX(), wid = __builtin_amdgcn_readfirstlane(tid >> 6), lane = tid & 63, r32 = lane & 31, hi = lane >> 5;
  const int s = wid >> 2, rg = wid & 3;
  LAS float* wsf = (LAS float*)(lds + D_WS) + wid * 64; LAS float* li_l = wsf; LAS float* al_l = wsf + 32;
  float m_reg = 0.f, l_reg = 0; f32x16 o[8] = {}; bf16x8 qr[8];
  const bf16_t* Qw = Q0 + (size_t)(rg * 32 + r32) * ldq + s * 128 + hi * 8;
#pragma unroll
  for (int d0 = 0; d0 < 8; ++d0) qr[d0] = *(const bf16x8*)(Qw + d0 * 16);
  const int NT = sa.nt + sb.nt;
  const int vrd = v_rd_base(lane);
#define DSTAGE(t, buf) do { const int t_ = (t); if (t_ < sa.nt) diff_stage(lds, (buf), sa, t_, wid, lane); else diff_stage(lds, (buf), sb, t_ - sa.nt, wid, lane); } while (0)
  DSTAGE(0, 0); asm volatile("s_waitcnt vmcnt(0)" ::: "memory"); __syncthreads();
  for (int t = 0; t < NT; ++t) {
    const int b = t & 1;
    if (t + 1 < NT) DSTAGE(t + 1, b ^ 1);
    f32x16 p0, p1; float mn, al; bf16x8 pa0, pa1, pa2, pa3;
    qkt(p0, p1, lds + b * DBUF + s * 16384, qr, opq_v(r32), hi);
    partialSM(p0, p1, m_reg, mn, al, l_reg);
    if (__any(al < 1.f)) { if (hi == 0) al_l[r32] = al; asm volatile("s_waitcnt lgkmcnt(0)" ::: "memory");
#pragma unroll
      for (int d = 0; d < 8; ++d)
#pragma unroll
        for (int r = 0; r < 16; ++r) o[d][r] *= al_l[crow(r, hi)]; }
    finishSM(p0, p1, al, l_reg, pa0, pa1, pa2, pa3); SBAR();
    const int vb = (int)(uintptr_t)(lds + b * DBUF + 32768) + vrd;
    pv_pipe<8>(o, vb, pa0, pa1, pa2, pa3);
    asm volatile("s_waitcnt vmcnt(0)" ::: "memory"); __syncthreads();
  }
#undef DSTAGE
  if (hi == 0) li_l[r32] = l_reg; asm volatile("s_waitcnt lgkmcnt(0)" ::: "memory");
  { float rli[16];
#pragma unroll
    for (int r = 0; r < 16; ++r) rli[r] = __builtin_amdgcn_rcpf(li_l[crow(r, hi)]);
#pragma unroll
    for (int d = 0; d < 8; ++d)
#pragma unroll
      for (int r = 0; r < 16; ++r) o[d][r] *= rli[r]; }
  LAS float* xch = (LAS float*)lds + (size_t)rg * 128 * 64 + lane;
  if (s == 1) {
#pragma unroll
    for (int d = 0; d < 8; ++d)
#pragma unroll
      for (int r = 0; r < 16; ++r) xch[(d * 16 + r) * 64] = o[d][r];
  }
  __syncthreads();
  if (s == 0) {
    float ss[16];
#pragma unroll
    for (int r = 0; r < 16; ++r) ss[r] = 0.f;
#pragma unroll
    for (int d = 0; d < 8; ++d)
#pragma unroll
      for (int r = 0; r < 16; ++r) { const float v = o[d][r] - lam * xch[(d * 16 + r) * 64]; o[d][r] = v; ss[r] += v * v; }
#pragma unroll
    for (int r = 0; r < 16; ++r) { float v = ss[r]; v += swz_xor<1>(v); v += swz_xor<2>(v); v += swz_xor<4>(v); v += swz_xor<8>(v); v += swz_xor<16>(v);
      ss[r] = __builtin_amdgcn_rsqf(v * (1.0f / 256.0f) + EPS); }
    bf16_t* Ow = Ob + (size_t)(rg * 32) * ldo + r32;
#pragma unroll
    for (int d = 0; d < 8; ++d) { const float g = gvec[d * 32 + r32] * (1.0f - LAM_INIT);
#pragma unroll
      for (int r = 0; r < 16; ++r) Ow[(size_t)crow(r, hi) * ldo + d * 32] = (bf16_t)(cvtpk(o[d][r] * ss[r] * g, 0.f) & 0xffffu); }
  }
  __syncthreads();
}
constexpr int NA_BUF = 32768, NA_WS = 3 * NA_BUF, NA_TB = NA_WS + 8 * 64 * 4;
__device__ __forceinline__ void na_stage(LAS char* lds, int buf, const KV& kv, int t, int wid, int lane) {
  const bf16_t* kp; const bf16_t* vp; int lk, lv;
  if (t < kv.nt0) { lk = kv.ldk0; lv = kv.ldv0; kp = kv.k0 + (size_t)t * 64 * lk; vp = kv.v0 + (size_t)t * 64 * lv; }
  else { int j = kv.base1 + (t - kv.nt0); j = j < kv.max1 ? j : kv.max1; lk = kv.ldk1; lv = kv.ldv1; kp = kv.k1 + (size_t)j * 64 * lk; vp = kv.v1 + (size_t)j * 64 * lv; }
  const int w3 = wid & 3;
  if (wid < 4) {
    LAS char* dst = lds + buf * NA_BUF + w3 * 4096;
    const char* src = (const char*)(kp + (size_t)(w3 * 16) * lk);
    const int rl = lane >> 4, cp = lane & 15;
    const unsigned ve = (unsigned)(rl * lk) * 2u + (unsigned)((cp ^ rl) * 16), vo = (unsigned)(rl * lk) * 2u + (unsigned)((cp ^ (rl + 4)) * 16);
#pragma unroll
    for (int i = 0; i < 4; ++i) { const char* p = src + (size_t)(4 * i) * lk * 2;
      __builtin_amdgcn_global_load_lds((const unsigned*)(p + ((i & 1) ? vo : ve)), (LAS unsigned*)(dst + i * 1024), 16, 0, 0); }
  } else {
    LAS char* dst = lds + buf * NA_BUF + 16384 + w3 * 4096;
    const char* src = (const char*)vp;
    const int q3 = (lane & 31) >> 2;
    const unsigned vl = (unsigned)((q3 * lv + (lane >> 5) * 32 + (lane & 3) * 8) * 2);
#pragma unroll
    for (int i = 0; i < 4; ++i) { const int ku = (w3 * 2 + (i >> 1)) * 8;
      const char* p = src + ((size_t)ku * lv + (i & 1) * 64) * 2;
      __builtin_amdgcn_global_load_lds((const unsigned*)(p + vl), (LAS unsigned*)(dst + i * 1024), 16, 0, 0); }
  }
}
__device__ __forceinline__ void attn_body_na2(const bf16_t* __restrict__ Qb, int ldq, const KV kv, int NT, bf16_t* __restrict__ Ob, int ldo, LAS char* lds, const NaW naw) {
  const int tid = TIDX(), wid = __builtin_amdgcn_readfirstlane(tid >> 6), lane = tid & 63, r32 = lane & 31, hi = lane >> 5;
  LAS float* wsf = (LAS float*)(lds + NA_WS) + wid * 64; LAS float* li_l = wsf; LAS float* al_l = wsf + 32;
  float m_reg = 0.f, l_reg = 0; f32x16 o[4] = {}; bf16x8 qr[8];
  const bf16_t* Qw = Qb + (size_t)(wid * 32 + r32) * ldq + hi * 8;
#pragma unroll
  for (int d0 = 0; d0 < 8; ++d0) qr[d0] = *(const bf16x8*)(Qw + d0 * 16);
  const int vrd = v_rd_base(lane);
#define NBAR() do { asm volatile("" ::: "memory"); __builtin_amdgcn_s_barrier(); asm volatile("" ::: "memory"); } while (0)
  asm volatile("s_waitcnt vmcnt(0)" ::: "memory");
  na_stage(lds, 0, kv, 0, wid, lane); if (NT > 1) na_stage(lds, 1, kv, 1, wid, lane);
  if (NT > 1) asm volatile("s_waitcnt vmcnt(4) lgkmcnt(0)" ::: "memory"); else asm volatile("s_waitcnt vmcnt(0) lgkmcnt(0)" ::: "memory");
  NBAR();
  int b = 0;
  for (int t = 0; t < NT; ++t) {
    const int b2 = b == 0 ? 2 : b - 1;
    if (t + 2 < NT) na_stage(lds, b2, kv, t + 2, wid, lane);
    const int kr = naw.rsmin + (t - kv.nt0);
    const bool lat = t >= kv.nt0;
    if (!lat || (kr >= naw.rsq && kr < naw.rsq + 8)) {
      f32x16 p0, p1; float mn, al; bf16x8 pa0, pa1, pa2, pa3;
      qkt(p0, p1, lds + b * NA_BUF, qr, opq_v(r32), hi);
      if (lat) na_mask(p0, p1, kr, naw, hi);
      partialSM(p0, p1, m_reg, mn, al, l_reg);
      if (__any(al < 1.f)) { if (hi == 0) al_l[r32] = al; asm volatile("s_waitcnt lgkmcnt(0)" ::: "memory");
#pragma unroll
        for (int d = 0; d < 4; ++d)
#pragma unroll
          for (int r = 0; r < 16; ++r) o[d][r] *= al_l[crow(r, hi)]; }
      finishSM(p0, p1, al, l_reg, pa0, pa1, pa2, pa3); SBAR();
      pv_d0(o, (int)(uintptr_t)(lds + b * NA_BUF + 16384) + vrd, pa0, pa1, pa2, pa3);
    }
    asm volatile("s_waitcnt lgkmcnt(0)" ::: "memory");
    if (t + 2 < NT) asm volatile("s_waitcnt vmcnt(4)" ::: "memory"); else asm volatile("s_waitcnt vmcnt(0)" ::: "memory");
    NBAR();
    b = b == 2 ? 0 : b + 1;
  }
#undef NBAR
  if (hi == 0) li_l[r32] = l_reg; asm volatile("s_waitcnt lgkmcnt(0)" ::: "memory");
  float rli[16];
#pragma unroll
  for (int r = 0; r < 16; ++r) rli[r] = __builtin_amdgcn_rcpf(li_l[crow(r, hi)]);
  bf16_t* Ow = Ob + (size_t)(wid * 32) * ldo;
#pragma unroll
  for (int r = 0; r < 16; ++r) { const int orow = crow(r, hi);
#pragma unroll
    for (int d0 = 0; d0 < 4; ++d0) Ow[(size_t)orow * ldo + d0 * 32 + r32] = (bf16_t)(cvtpk(o[d0][r] * rli[r], 0.f) & 0xffffu); }
  asm volatile("s_waitcnt vmcnt(0)" ::: "memory");
}
}

#define XB_TMO      128
#define XB_XCNT(j)  (256  + 64 * (j))
#define XB_XSUB(j)  (1280 + 64 * (j))
#define XB_XGEN(j)  (2304 + 64 * (j))
#define XB_TOP      3328
#define XB_TOPGEN   3392
#define XCD_BAR_WORDS 3456
#define XB_SPIN_CAP (1u << 18)
__device__ __forceinline__ unsigned xb_ld(unsigned* p)              { return __hip_atomic_load(p, __ATOMIC_RELAXED, __HIP_MEMORY_SCOPE_AGENT); }
__device__ __forceinline__ unsigned xb_add(unsigned* p, unsigned v) { return __hip_atomic_fetch_add(p, v, __ATOMIC_RELAXED, __HIP_MEMORY_SCOPE_AGENT); }
__device__ __forceinline__ unsigned xb_xcc_id() { return (unsigned)__builtin_amdgcn_s_getreg((3 << 11) | 20) & 0xFu; }
#define XB_SPIN(cond, bar) do { unsigned _sp = 0; while (cond) { __builtin_amdgcn_s_sleep(1); \
    if ((++_sp & 255u) == 0u) { if (xb_ld(&(bar)[XB_TMO])) break; if (_sp > XB_SPIN_CAP) { atomicAdd(&(bar)[XB_TMO], 1u); break; } } } } while (0)
struct XcdBarrier { unsigned* bar; unsigned x; volatile LAS unsigned* st; };
__device__ __forceinline__ XcdBarrier xcd_barrier_post(unsigned* bar, volatile LAS unsigned* st) {
    XcdBarrier b; b.bar = bar; b.x = xb_xcc_id(); b.st = st;
    if (TIDX() == 0) (void)xb_add(&bar[XB_XCNT(b.x)], 1u);
    return b;
}
__device__ __forceinline__ void xcd_barrier_complete(unsigned* bar, unsigned x, unsigned& nloc, unsigned& nx) {
    const unsigned G = gridDim.x * gridDim.y * gridDim.z;
    unsigned sum, cnt, mine, sp = 0u;
    for (;;) {
        sum = 0u; cnt = 0u; mine = 0u;
#pragma unroll
        for (unsigned j = 0; j < 16; ++j) { const unsigned c = xb_ld(&bar[XB_XCNT(j)]); sum += c; cnt += (c > 0u) ? 1u : 0u; mine = (j == x) ? c : mine; }
        if (sum == G) break;
        __builtin_amdgcn_s_sleep(1);
        if ((++sp & 255u) == 0u) { if (xb_ld(&bar[XB_TMO])) break; if (sp > XB_SPIN_CAP) { atomicAdd(&bar[XB_TMO], 1u); break; } }
    }
    nloc = mine > 0u ? mine : 1u; nx = cnt > 0u ? cnt : 1u;
}
__device__ __forceinline__ void xcd_barrier(const XcdBarrier& b) {
    asm volatile("s_waitcnt vmcnt(0)" ::: "memory");
    __syncthreads();
    if (TIDX() == 0) {
        unsigned* bar = b.bar;
        __builtin_amdgcn_s_waitcnt(0);
        unsigned nloc = b.st[0], nx = b.st[1];
        if (nloc == 0u) { xcd_barrier_complete(bar, b.x, nloc, nx); b.st[0] = nloc; b.st[1] = nx; }
        const unsigned old = xb_add(&bar[XB_XSUB(b.x)], 1u);
        const unsigned gen = old / nloc;
        if (old + 1u == (gen + 1u) * nloc) {
            __builtin_amdgcn_fence(__ATOMIC_RELEASE, "agent");
            asm volatile("s_waitcnt vmcnt(0)" ::: "memory");
            const unsigned og = xb_add(&bar[XB_TOP], 1u);
            const unsigned tg = og / nx;
            if (og + 1u == (tg + 1u) * nx) xb_add(&bar[XB_TOPGEN], 1u);
            else XB_SPIN(xb_ld(&bar[XB_TOPGEN]) == tg, bar);
            __builtin_amdgcn_fence(__ATOMIC_ACQUIRE, "agent");
            xb_add(&bar[XB_XGEN(b.x)], 1u);
            asm volatile("s_waitcnt vmcnt(0)" ::: "memory");
        } else {
            XB_SPIN(xb_ld(&bar[XB_XGEN(b.x)]) == gen, bar);
            __builtin_amdgcn_fence(__ATOMIC_ACQUIRE, "agent");
            asm volatile("s_waitcnt vmcnt(0)" ::: "memory");
        }
    }
    __syncthreads();
}


__device__ __forceinline__ float wave_sum(float v) {
    v += swz_xor<1>(v); v += swz_xor<2>(v); v += swz_xor<4>(v); v += swz_xor<8>(v); v += swz_xor<16>(v);
    { auto rr = __builtin_amdgcn_permlane32_swap(__float_as_uint(v), __float_as_uint(v), false, false); v = __uint_as_float(rr[0]) + __uint_as_float(rr[1]); }
    return v;
}
__device__ __forceinline__ unsigned pk2(float lo, float hi) { return pg8::cvt_pk_bf16(lo, hi); }

struct Args { const float* in[26]; float* out; unsigned char* ws; int ph_lo, ph_hi; };

__device__ __forceinline__ void transpose_item(const float* W, int N, int K, bf16_t* WT, int k0, int n0, int r0a, int r0b, LAS float* scr, int lane) {
#pragma unroll 8
    for (int i = 0; i < 64; ++i) scr[i * 65 + lane] = W[(size_t)(k0 + i) * N + n0 + lane];
    asm volatile("s_waitcnt lgkmcnt(0)" ::: "memory");
    const int c = lane & 7;
#pragma unroll
    for (int j = 0; j < 8; ++j) { const int n = (lane >> 3) + 8 * j; const LAS float* s = scr + (8 * c) * 65 + n;
        u32x4 o; o.x = pk2(s[0 * 65], s[1 * 65]); o.y = pk2(s[2 * 65], s[3 * 65]); o.z = pk2(s[4 * 65], s[5 * 65]); o.w = pk2(s[6 * 65], s[7 * 65]);
        const int row = (j < 4 ? r0a : r0b - 32) + n;
        const int nl = row & 127, p = nl & 31, R = (nl & ~31) + ((p >> 2) & 1) * 16 + (p >> 3) * 4 + (p & 3);
        *(u32x4*)((char*)WT + (((size_t)(row >> 8) * (K >> 6) + (k0 >> 6)) * 2 + ((row >> 7) & 1)) * 16384 + pg8::lds_byte(R, 8 * c)) = o; }
    asm volatile("s_waitcnt lgkmcnt(0)" ::: "memory");
}
template <int MAP> __device__ __forceinline__ int map_row32(int n32) {
    if (MAP == 1) return (n32 >> 7) * 256 + (n32 & 127);
    if (MAP == 2) return (n32 >> 7) * 256 + 128 + (n32 & 127);
    if (MAP == 3) { if (n32 >= 4096) return n32; const int t = n32 >> 8, hp = (n32 >> 7) & 1, part = (n32 >> 6) & 1, x = (n32 >> 5) & 1; return t * 256 + x * 128 + hp * 64 + part * 32; }
    return n32;
}
template <int MAP> __device__ __forceinline__ void transpose_matrix(const float* W, int K, int N, bf16_t* WT, int gw, int ngw, LAS float* scr, int lane) {
    const int nbn = N / 64, nit = (K / 64) * nbn;
    for (int it = gw; it < nit; it += ngw) { const int kb = it / nbn, nb = it % nbn;
        transpose_item(W, N, K, WT, kb * 64, nb * 64, map_row32<MAP>(nb * 64), map_row32<MAP>(nb * 64 + 32), scr, lane); }
}
__device__ __forceinline__ void cvt_array(const float* src, bf16_t* dst, size_t n8, size_t gt, size_t ngt) {
    for (size_t i = gt; i < n8; i += ngt) { const f32x4 a = *(const f32x4*)(src + i * 8), b = *(const f32x4*)(src + i * 8 + 4);
        u32x4 w; w.x = pk2(a[0], a[1]); w.y = pk2(a[2], a[3]); w.z = pk2(b[0], b[1]); w.w = pk2(b[2], b[3]); *(u32x4*)(dst + i * 8) = w; }
}

__device__ __forceinline__ void phase_prologue(const Args& a, LAS unsigned char* lds, int vcu, int G) {
    const int tid = TIDX(), lane = tid & 63, wave = tid >> 6;
    unsigned char* ws = a.ws;
    if (vcu < 144) {
        LAS float* sc = (LAS float*)lds;
        LAS f32x4* red = (LAS f32x4*)(lds + 65536);
        for (int i = tid; i < 2048 * 8; i += 512) { const int k = i >> 3, b = i & 7; float v = 0.f;
            if (b < 5) { const float x = (b == 0) ? a.in[7][k] : a.in[2][(b - 1) * 2048 + k]; v = x / (1.0f + __expf(-x)); }
            sc[i] = v; }
        __syncthreads();
        for (int u = vcu; u < 144; u += G) {
            const int l = u / 72, cg = u % 72;
            const float* W = a.in[8] + (size_t)l * 2048 * 18432 + cg * 256 + lane * 4;
            f32x4 acc[5];
#pragma unroll
            for (int b = 0; b < 5; ++b) acc[b] = (f32x4){0.f, 0.f, 0.f, 0.f};
            const int kb = wave * 256;
#pragma unroll 8
            for (int k = 0; k < 256; ++k) { const f32x4 wv = *(const f32x4*)(W + (size_t)(kb + k) * 18432);
                const f32x4 s03 = *(const LAS f32x4*)(sc + (kb + k) * 8); const float s4 = sc[(kb + k) * 8 + 4];
                acc[0] += wv * s03[0]; acc[1] += wv * s03[1]; acc[2] += wv * s03[2]; acc[3] += wv * s03[3]; acc[4] += wv * s4; }
#pragma unroll
            for (int b = 0; b < 5; ++b) red[(wave * 5 + b) * 64 + lane] = acc[b];
            __syncthreads();
            if (tid < 320) { const int b = tid >> 6; f32x4 s = red[b * 64 + lane];
#pragma unroll
                for (int w = 1; w < 8; ++w) s += red[(w * 5 + b) * 64 + lane];
                const int n = cg * 256 + lane * 4;
                s += *(const f32x4*)(a.in[9] + (size_t)l * 18432 + n);
                *(f32x4*)((float*)(ws + WS_MOD) + ((size_t)l * 5 + b) * 18432 + n) = s; }
            __syncthreads();
        }
    }
    __syncthreads();
    const int ngw = G * 8; const int gw = ((vcu + 112) % G) * 8 + wave;
    LAS float* scr = (LAS float*)(lds + wave * 16640);
    for (int li = 0; li < 4; ++li) {
        transpose_matrix<1>(a.in[11] + (size_t)li * DM * DFF, DM, DFF, (bf16_t*)(ws + WS_W13 + li * W13_BYTES), gw, ngw, scr, lane);
        transpose_matrix<2>(a.in[12] + (size_t)li * DM * DFF, DM, DFF, (bf16_t*)(ws + WS_W13 + li * W13_BYTES), gw, ngw, scr, lane);
        transpose_matrix<0>(a.in[13] + (size_t)li * DFF * DM, DFF, DM, (bf16_t*)(ws + WS_W2 + li * W2_BYTES), gw, ngw, scr, lane);
    }
    transpose_matrix<0>(a.in[14], DM, INA, (bf16_t*)(ws + WS_WINA), gw, ngw, scr, lane);
    transpose_matrix<3>(a.in[21], DM, INC, (bf16_t*)(ws + WS_WINC), gw, ngw, scr, lane);
    transpose_matrix<0>(a.in[15], DM, DM, (bf16_t*)(ws + WS_WOA), gw, ngw, scr, lane);
    transpose_matrix<0>(a.in[22], DM, DM, (bf16_t*)(ws + WS_WOC), gw, ngw, scr, lane);
    const size_t gt = (size_t)vcu * 512 + tid, ngt = (size_t)G * 512;
    cvt_array(a.in[3], (bf16_t*)(ws + WS_CAK), 2097152 / 8, gt, ngt);
    cvt_array(a.in[4], (bf16_t*)(ws + WS_CAV), 2097152 / 8, gt, ngt);
    cvt_array(a.in[5], (bf16_t*)(ws + WS_CCK), 4194304 / 8, gt, ngt);
    cvt_array(a.in[6], (bf16_t*)(ws + WS_CCV), 4194304 / 8, gt, ngt);
    if (gt < 2048) { const int pos = (int)gt >> 5, i = (int)gt & 31; const float inv = powf(10000.0f, -(float)i / 32.0f); const float ang = (float)pos * inv;
        ((float*)(ws + WS_ROPE))[gt] = cosf(ang); ((float*)(ws + WS_ROPE))[2048 + gt] = sinf(ang); }
}

__device__ __forceinline__ char* h_tiled(bf16_t* H, int row, int col) {
    return (char*)H + (((size_t)(row >> 8) * (DM / 64) + (col >> 6)) * 2 + ((row >> 7) & 1)) * 16384 + pg8::lds_byte(row & 127, col & 63);
}
__device__ __forceinline__ void load_xrow(const Args& a, int first, int row, int lane, f32x4 (&v)[8]) {
    if (first) { const float* xr = row < NCTX ? a.in[0] + (size_t)row * DM : a.in[1] + (size_t)(row - NCTX) * DM;
#pragma unroll
        for (int j = 0; j < 8; ++j) v[j] = *(const f32x4*)(xr + 4 * lane + 256 * j);
    } else { const bf16_t* xr = (const bf16_t*)(a.ws + WS_X) + (size_t)row * XS;
#pragma unroll
        for (int j = 0; j < 8; ++j) { const u32x2 w = *(const u32x2*)(xr + 4 * lane + 256 * j);
            v[j] = (f32x4){__uint_as_float(w.x << 16), __uint_as_float(w.x & 0xffff0000u), __uint_as_float(w.y << 16), __uint_as_float(w.y & 0xffff0000u)}; } }
}
__device__ __forceinline__ void phase_norm(const Args& a, int vcu, int G, int first, int l, int sub) {
    const int tid = TIDX(), lane = tid & 63, wave = tid >> 6;
    const int gw = vcu * 8 + wave, ngw = G * 8;
    const int rows_per = (MTOK + ngw - 1) / ngw;
    const float* gvec = a.in[10] + ((size_t)l * 3 + sub) * DM;
    const float* mbase = (const float*)(a.ws + WS_MOD) + (size_t)l * 5 * 18432 + (size_t)(3 * sub) * DM;
    bf16_t* H = (bf16_t*)(a.ws + WS_H);
    int cur_mi = -1; f32x4 A[8], B[8], vn[8];
    if (gw * rows_per < MTOK) load_xrow(a, first, gw * rows_per, lane, vn);
    for (int rr = 0; rr < rows_per; ++rr) {
        const int row = gw * rows_per + rr; if (row >= MTOK) break;
        const int mi = row < NCTX ? 0 : 1 + ((row - NCTX) >> 12);
        if (mi != cur_mi) { cur_mi = mi; const float* mv = mbase + (size_t)mi * 18432;
#pragma unroll
            for (int j = 0; j < 8; ++j) { const int c = 4 * lane + 256 * j; const f32x4 g = *(const f32x4*)(gvec + c), sh = *(const f32x4*)(mv + c), scl = *(const f32x4*)(mv + DM + c);
                A[j] = g * (1.0f + scl); B[j] = sh; } }
        f32x4 v[8]; float s = 0.f;
#pragma unroll
        for (int j = 0; j < 8; ++j) v[j] = vn[j];
        if (rr + 1 < rows_per && row + 1 < MTOK) load_xrow(a, first, row + 1, lane, vn);
#pragma unroll
        for (int j = 0; j < 8; ++j) s += (v[j][0] * v[j][0] + v[j][1] * v[j][1]) + (v[j][2] * v[j][2] + v[j][3] * v[j][3]);
        const float rstd = 1.0f / sqrtf(wave_sum(s) * (1.0f / DM) + EPS);
        bf16_t* hr = H + (size_t)row * DM;
#pragma unroll
        for (int j = 0; j < 8; ++j) { const f32x4 y = v[j] * rstd * A[j] + B[j]; u32x2 w; w.x = pk2(y[0], y[1]); w.y = pk2(y[2], y[3]); *(u32x2*)(hr + 4 * lane + 256 * j) = w; }
    }
}
__device__ __forceinline__ void load_xrow_packed(const Args& a, int row, int lane, u32x2 (&p)[8]) {
    const bf16_t* xr = (const bf16_t*)(a.ws + WS_X) + (size_t)row * XS;
#pragma unroll
    for (int j = 0; j < 8; ++j) p[j] = *(const u32x2*)(xr + 4 * lane + 256 * j);
}
__device__ __forceinline__ void phase_norm_pairs(const Args& a, int vcu, int G, int l, int sub) {
    const int tid = TIDX(), lane = tid & 63, wave = tid >> 6;
    const int gw = vcu * 8 + wave, ngw = G * 8;
    const int rows_per = (MTOK + ngw - 1) / ngw;
    const float* gvec = a.in[10] + ((size_t)l * 3 + sub) * DM;
    const float* mbase = (const float*)(a.ws + WS_MOD) + (size_t)l * 5 * 18432 + (size_t)(3 * sub) * DM;
    bf16_t* H = (bf16_t*)(a.ws + WS_H);
    int cur_mi = -1; f32x4 A[8], B[8]; u32x2 pn0[8], pn1[8];
    const int rbase = gw * rows_per;
    if (rbase < MTOK) load_xrow_packed(a, rbase, lane, pn0);
    if (rows_per > 1 && rbase + 1 < MTOK) load_xrow_packed(a, rbase + 1, lane, pn1);
    for (int rr = 0; rr < rows_per; rr += 2) {
        const int row = rbase + rr; if (row >= MTOK) break;
        const bool two = (rr + 1 < rows_per) && (row + 1 < MTOK);
        u32x2 p0[8], p1[8];
#pragma unroll
        for (int j = 0; j < 8; ++j) { p0[j] = pn0[j]; p1[j] = pn1[j]; }
        if (rr + 2 < rows_per && row + 2 < MTOK) load_xrow_packed(a, row + 2, lane, pn0);
        if (rr + 3 < rows_per && row + 3 < MTOK) load_xrow_packed(a, row + 3, lane, pn1);
#pragma unroll
        for (int h = 0; h < 2; ++h) {
            if (h == 1 && !two) break;
            const int r = row + h;
            const int mi = r < NCTX ? 0 : 1 + ((r - NCTX) >> 12);
            if (mi != cur_mi) { cur_mi = mi; const float* mv = mbase + (size_t)mi * 18432;
#pragma unroll
                for (int j = 0; j < 8; ++j) { const int c = 4 * lane + 256 * j; const f32x4 g = *(const f32x4*)(gvec + c), sh = *(const f32x4*)(mv + c), scl = *(const f32x4*)(mv + DM + c);
                    A[j] = g * (1.0f + scl); B[j] = sh; } }
            f32x4 v[8]; float s = 0.f;
#pragma unroll
            for (int j = 0; j < 8; ++j) { const u32x2 w = h ? p1[j] : p0[j];
                v[j] = (f32x4){__uint_as_float(w.x << 16), __uint_as_float(w.x & 0xffff0000u), __uint_as_float(w.y << 16), __uint_as_float(w.y & 0xffff0000u)};
                s += (v[j][0] * v[j][0] + v[j][1] * v[j][1]) + (v[j][2] * v[j][2] + v[j][3] * v[j][3]); }
            const float rstd = 1.0f / sqrtf(wave_sum(s) * (1.0f / DM) + EPS);
            bf16_t* hr = H + (size_t)r * DM;
#pragma unroll
            for (int j = 0; j < 8; ++j) { const f32x4 y = v[j] * rstd * A[j] + B[j]; u32x2 w; w.x = pk2(y[0], y[1]); w.y = pk2(y[2], y[3]); *(u32x2*)(hr + 4 * lane + 256 * j) = w; }
        }
    }
}
template <bool FIRST> __device__ __forceinline__ void phase_norm_tiled(const Args& a, LAS unsigned char* lds, int vcu, int G, int l, int sub) {
    const int tid = TIDX(), lane = tid & 63, wave = tid >> 6;
    const float* gvec = a.in[10] + ((size_t)l * 3 + sub) * DM;
    const float* mbase = (const float*)(a.ws + WS_MOD) + (size_t)l * 5 * 18432 + (size_t)(3 * sub) * DM;
    char* H = (char*)(a.ws + WS_H);
    const int base = vcu * (MTOK / G);
    int cur_mi = -1; f32x4 A[8], B[8]; u32x2 pn0[8], pn1[8];
    if (!FIRST) { load_xrow_packed(a, base + 2 * wave, lane, pn0); load_xrow_packed(a, base + 2 * wave + 1, lane, pn1); }
    for (int k = 0; k < (MTOK / G) / 16; ++k) {
        const int r0 = base + 16 * k + 2 * wave;
        u32x2 p0[8], p1[8];
        if (!FIRST) {
#pragma unroll
            for (int j = 0; j < 8; ++j) { p0[j] = pn0[j]; p1[j] = pn1[j]; }
            if (k + 1 < (MTOK / G) / 16) { load_xrow_packed(a, r0 + 16, lane, pn0); load_xrow_packed(a, r0 + 17, lane, pn1); } }
#pragma unroll
        for (int h = 0; h < 2; ++h) {
            const int r = r0 + h;
            const int mi = r < NCTX ? 0 : 1 + ((r - NCTX) >> 12);
            if (mi != cur_mi) { cur_mi = mi; const float* mv = mbase + (size_t)mi * 18432;
#pragma unroll
                for (int j = 0; j < 8; ++j) { const int c = 4 * lane + 256 * j; const f32x4 g = *(const f32x4*)(gvec + c), sh = *(const f32x4*)(mv + c), scl = *(const f32x4*)(mv + DM + c);
                    A[j] = g * (1.0f + scl); B[j] = sh; } }
            f32x4 v[8]; float s = 0.f;
            if (FIRST) load_xrow(a, 1, r, lane, v);
#pragma unroll
            for (int j = 0; j < 8; ++j) {
                if (!FIRST) { const u32x2 w = h ? p1[j] : p0[j];
                    v[j] = (f32x4){__uint_as_float(w.x << 16), __uint_as_float(w.x & 0xffff0000u), __uint_as_float(w.y << 16), __uint_as_float(w.y & 0xffff0000u)}; }
                s += (v[j][0] * v[j][0] + v[j][1] * v[j][1]) + (v[j][2] * v[j][2] + v[j][3] * v[j][3]); }
            const float rstd = 1.0f / sqrtf(wave_sum(s) * (1.0f / DM) + EPS);
            const int rl = 2 * wave + h, cc = 4 * (lane & 15);
            const int ob = rl * 64 + (cc & 31) * 2, so = (cc >> 5) * 1024 + (ob ^ (((ob >> 9) & 1) << 5));
#pragma unroll
            for (int j = 0; j < 8; ++j) { const f32x4 y = v[j] * rstd * A[j] + B[j]; u32x2 w; w.x = pk2(y[0], y[1]); w.y = pk2(y[2], y[3]);
                *(LAS u32x2*)(lds + (k & 1) * 65536 + ((lane >> 4) + 4 * j) * 2048 + so) = w; }
        }
        __syncthreads();
        { const int row = base + 16 * k;
          char* dst = H + (((size_t)(row >> 8) * (DM / 64)) * 2 + ((row >> 7) & 1)) * 16384 + ((row >> 4) & 7) * 2048;
#pragma unroll
          for (int i = 0; i < 8; ++i) { const int q = tid + 512 * i;
              *(u32x4*)(dst + (size_t)(q >> 7) * 32768 + (q & 127) * 16) = *(const LAS u32x4*)(lds + (k & 1) * 65536 + q * 16); } }
    }
    __syncthreads();
}

__device__ __forceinline__ void phase_final(const Args& a, int vcu, int G) {
    const int tid = TIDX(), lane = tid & 63, wave = tid >> 6;
    const int gw = vcu * 8 + wave, ngw = G * 8;
    const float* g = a.in[25];
    f32x4 gv[8];
#pragma unroll
    for (int j = 0; j < 8; ++j) gv[j] = *(const f32x4*)(g + 4 * lane + 256 * j);
    f32x4 vn[8];
    if (gw < MTOK) load_xrow(a, 0, gw, lane, vn);
    for (int row = gw; row < MTOK; row += ngw) {
        f32x4 v[8]; float s = 0.f;
#pragma unroll
        for (int j = 0; j < 8; ++j) v[j] = vn[j];
        if (row + ngw < MTOK) load_xrow(a, 0, row + ngw, lane, vn);
#pragma unroll
        for (int j = 0; j < 8; ++j) s += (v[j][0] * v[j][0] + v[j][1] * v[j][1]) + (v[j][2] * v[j][2] + v[j][3] * v[j][3]);
        const float rstd = 1.0f / sqrtf(wave_sum(s) * (1.0f / DM) + EPS);
        float* orow = a.out + (size_t)row * DM;
#pragma unroll
        for (int j = 0; j < 8; ++j) *(f32x4*)(orow + 4 * lane + 256 * j) = v[j] * rstd * gv[j];
    }
}

__device__ __forceinline__ float bf_lo(unsigned u) { return __uint_as_float(u << 16); }
__device__ __forceinline__ float bf_hi(unsigned u) { return __uint_as_float(u & 0xffff0000u); }
__device__ __forceinline__ float ldu_f32(const float* ubase, unsigned voff_bytes) { return *(const float*)((const char*)ubase + voff_bytes); }
__device__ __forceinline__ float glu1(float av, float gv) { return av * __builtin_amdgcn_rcpf(1.0f + __builtin_amdgcn_exp2f(-1.4426950408889634f * gv)); }
__device__ __forceinline__ void conv_item(const Args& a, LAS unsigned char* lds, int item) {
    const int tid = TIDX(), lane = tid & 63, wave = tid >> 6;
    const bf16_t* QKV = (const bf16_t*)(a.ws + WS_U); bf16_t* AO = (bf16_t*)(a.ws + WS_AO);
    const int t0 = item * 16;
    const int seq_lo = t0 < NCTX ? (t0 & ~255) : NCTX + ((t0 - NCTX) & ~4095);
    const int seq_hi = t0 < NCTX ? seq_lo + 256 : seq_lo + 4096;
    LAS float* zs = (LAS float*)lds;
    LAS float* os = (LAS float*)(lds + 49152);
    LAS float* st = (LAS float*)(lds + 49152 + 65536);
    LAS float* st2 = st + 128;
    const int ch = tid & 255, half = tid >> 8;
    float psum[8], psq[8];
#pragma unroll
    for (int i = 0; i < 8; ++i) { psum[i] = 0.f; psq[i] = 0.f; }
    u32x4 av[3], gv[3]; float wreg[31], bias; float wnext[31], bnext; u32x4 avn[3], gvn[3];
    bool okk[3];
#pragma unroll
    for (int k = 0; k < 3; ++k) { const int g = tid + 512 * k, row = g >> 5, tok = t0 - 15 + row; okk[k] = (g < 1472) && tok >= seq_lo && tok < seq_hi; }
#define CONV_LOAD(cc_, AV, GV, WR, BI) do { _Pragma("unroll") for (int k = 0; k < 3; ++k) { const int g = tid + 512 * k; int row = g >> 5; row = row > 45 ? 45 : row; const int c8 = (g & 31) * 8; int tok = t0 - 15 + row; \
        tok = tok < seq_lo ? seq_lo : (tok >= seq_hi ? seq_hi - 1 : tok); const bf16_t* p = QKV + (size_t)tok * INA + 3072 + (cc_) * 256 + c8; AV[k] = *(const u32x4*)p; GV[k] = *(const u32x4*)(p + 1024); } \
        { const float* wp_ = a.in[17] + (cc_) * 256 + ch; _Pragma("unroll") for (int w = 0; w < 31; ++w) WR[w] = wp_[w * 1024]; BI = a.in[18][(cc_) * 256 + ch]; } } while (0)
    CONV_LOAD(0, av, gv, wreg, bias);
#pragma unroll 1
    for (int cc = 0; cc < 4; ++cc) {
        const int c = cc * 256 + ch;
        __syncthreads();
#pragma unroll
        for (int k = 0; k < 3; ++k) { const int g = tid + 512 * k, row = g >> 5, c8 = (g & 31) * 8;
            if (g < 1472) { f32x4 z0, z1; const u32x4 A_ = okk[k] ? av[k] : (u32x4){0u, 0u, 0u, 0u}; const u32x4 G_ = gv[k];
                z0[0] = glu1(bf_lo(A_.x), bf_lo(G_.x)); z0[1] = glu1(bf_hi(A_.x), bf_hi(G_.x)); z0[2] = glu1(bf_lo(A_.y), bf_lo(G_.y)); z0[3] = glu1(bf_hi(A_.y), bf_hi(G_.y));
                z1[0] = glu1(bf_lo(A_.z), bf_lo(G_.z)); z1[1] = glu1(bf_hi(A_.z), bf_hi(G_.z)); z1[2] = glu1(bf_lo(A_.w), bf_lo(G_.w)); z1[3] = glu1(bf_hi(A_.w), bf_hi(G_.w));
                *(LAS f32x4*)(zs + row * 256 + c8) = z0; *(LAS f32x4*)(zs + row * 256 + c8 + 4) = z1; } }
        __syncthreads();
        { const int cn = cc < 3 ? cc + 1 : 3; CONV_LOAD(cn, avn, gvn, wnext, bnext); }
        float acc[8];
#pragma unroll
        for (int i = 0; i < 8; ++i) acc[i] = bias;
#pragma unroll
        for (int j = 0; j < 38; ++j) { const float z = zs[(half * 8 + j) * 256 + ch];
#pragma unroll
            for (int i = 0; i < 8; ++i) { const int w = j - i; if (w >= 0 && w < 31) acc[i] = fmaf(z, wreg[w], acc[i]); } }
#pragma unroll
        for (int i = 0; i < 8; ++i) { os[(half * 8 + i) * 1024 + c] = acc[i]; psum[i] += acc[i]; psq[i] += acc[i] * acc[i]; }
#pragma unroll
        for (int k = 0; k < 3; ++k) { av[k] = avn[k]; gv[k] = gvn[k]; }
#pragma unroll
        for (int w = 0; w < 31; ++w) wreg[w] = wnext[w];
        bias = bnext;
    }
#undef CONV_LOAD
#pragma unroll
    for (int i = 0; i < 8; ++i) { const float s = wave_sum(psum[i]), q = wave_sum(psq[i]); if (lane == 0) { st[(wave * 8 + i) * 2] = s; st[(wave * 8 + i) * 2 + 1] = q; } }
    __syncthreads();
    if (tid < 16) { const int hf = tid >> 3, i = tid & 7; float s = 0.f, q = 0.f;
#pragma unroll
        for (int w = 0; w < 4; ++w) { s += st[((hf * 4 + w) * 8 + i) * 2]; q += st[((hf * 4 + w) * 8 + i) * 2 + 1]; }
        const float mean = s * (1.0f / 1024.0f), var = q * (1.0f / 1024.0f) - mean * mean;
        st2[tid * 2] = mean; st2[tid * 2 + 1] = 1.0f / sqrtf(var + EPS); }
    __syncthreads();
    { const int c8 = (tid & 127) * 8, tq = tid >> 7;
      const f32x4 g0 = *(const f32x4*)(a.in[19] + c8), g1 = *(const f32x4*)(a.in[19] + c8 + 4), b0 = *(const f32x4*)(a.in[20] + c8), b1 = *(const f32x4*)(a.in[20] + c8 + 4);
#pragma unroll
      for (int k = 0; k < 4; ++k) { const int t = tq * 4 + k; const f32x4 v0 = *(const LAS f32x4*)(os + t * 1024 + c8), v1 = *(const LAS f32x4*)(os + t * 1024 + c8 + 4);
        const float mean = st2[t * 2], rstd = st2[t * 2 + 1];
        f32x4 y0 = (v0 - mean) * rstd * g0 + b0, y1 = (v1 - mean) * rstd * g1 + b1;
#pragma unroll
        for (int e = 0; e < 4; ++e) { y0[e] = y0[e] * __builtin_amdgcn_rcpf(1.0f + __builtin_amdgcn_exp2f(-1.4426950408889634f * y0[e])); y1[e] = y1[e] * __builtin_amdgcn_rcpf(1.0f + __builtin_amdgcn_exp2f(-1.4426950408889634f * y1[e])); }
        u32x4 w; w.x = pk2(y0[0], y0[1]); w.y = pk2(y0[2], y0[3]); w.z = pk2(y1[0], y1[1]); w.w = pk2(y1[2], y1[3]);
        *(u32x4*)(AO + (size_t)(t0 + t) * DM + 1024 + c8) = w; } }
    __syncthreads();
}

#ifndef SD_DENSE
#define SD_DENSE 2
#endif
__device__ __forceinline__ void phase_mix_even(const Args& a, LAS unsigned char* lds, int vcu, int G) {
    const int tid = TIDX();
    const bf16_t* QKV = (const bf16_t*)(a.ws + WS_U); bf16_t* AO = (bf16_t*)(a.ws + WS_AO);
    const bf16_t* CAK = (const bf16_t*)(a.ws + WS_CAK); const bf16_t* CAV = (const bf16_t*)(a.ws + WS_CAV);
    for (int it = vcu; it < 512; it += G) {
        const int qb = it & 15, h = (it >> 4) & 7, b = it >> 7;
        LAS float* tb = (LAS float*)(lds + att::NA_TB);
        for (int i = tid; i < 465; i += 512) tb[i] = a.in[16][h * 465 + i] * 1.4426950408889634f;
        const int r0 = qb * 4; int rsmin = r0 - 4; rsmin = rsmin < 0 ? 0 : (rsmin > 56 ? 56 : rsmin);
        const int wid = tid >> 6, lane = tid & 63;
        att::NaW w; w.qrow = r0 + (wid >> 1); int rsq = w.qrow - 4; w.rsq = rsq < 0 ? 0 : (rsq > 56 ? 56 : rsq);
        w.c = (wid & 1) * 32 + (lane & 31); int cs = w.c - 8; w.cs = cs < 0 ? 0 : (cs > 48 ? 48 : cs); w.rsmin = rsmin; w.tb = tb;
        const size_t lat0 = (size_t)(NCTX + b * 4096);
        att::KV kv; kv.k0 = CAK + (size_t)(b * 8 + h) * 512 * 128; kv.v0 = CAV + (size_t)(b * 8 + h) * 512 * 128; kv.ldk0 = 128; kv.ldv0 = 128; kv.nt0 = 8;
        kv.k1 = QKV + lat0 * INA + 1024 + h * 128; kv.v1 = QKV + lat0 * INA + 2048 + h * 128; kv.ldk1 = INA; kv.ldv1 = INA; kv.base1 = rsmin; kv.max1 = 63;
        att::attn_body_na2(QKV + (lat0 + qb * 256) * INA + h * 128, INA, kv, 19, AO + (lat0 + qb * 256) * DM + h * 128, DM, (LAS char*)lds, w);
    }
    for (int it = vcu; it < 128; it += G) {
        const int h = it & 7, b = it >> 3; const size_t r0 = (size_t)b * 256;
        att::KV kv; kv.k0 = QKV + r0 * INA + 1024 + h * 128; kv.v0 = QKV + r0 * INA + 2048 + h * 128; kv.ldk0 = INA; kv.ldv0 = INA; kv.nt0 = 4;
        kv.k1 = kv.k0; kv.v1 = kv.v0; kv.ldk1 = INA; kv.ldv1 = INA; kv.base1 = 0; kv.max1 = 0;
        att::NaW w{};
        att::attn_body<0, SD_DENSE>(QKV + r0 * INA + h * 128, INA, kv, 4, AO + r0 * DM + h * 128, DM, (LAS char*)lds, w);
    }
    __syncthreads();
    for (int it = vcu; it < MTOK / 16; it += G) conv_item(a, lds, it);
}
__device__ __forceinline__ void phase_mix_odd(const Args& a, LAS unsigned char* lds, int vcu, int G) {
    const bf16_t* QKV = (const bf16_t*)(a.ws + WS_U); bf16_t* AO = (bf16_t*)(a.ws + WS_AO);
    const bf16_t* CCK = (const bf16_t*)(a.ws + WS_CCK); const bf16_t* CCV = (const bf16_t*)(a.ws + WS_CCV);
    const int lane = TIDX() & 63;
    const float* lp = a.in[23];
    float s1 = lp[lane] * lp[128 + lane] + lp[64 + lane] * lp[192 + lane], s2 = lp[256 + lane] * lp[384 + lane] + lp[320 + lane] * lp[448 + lane];
    s1 = wave_sum(s1); s2 = wave_sum(s2);
    const float lam = expf(s1) - expf(s2) + LAM_INIT;
    for (int it = vcu; it < 1024; it += G) {
        const int qb = it & 31, h = (it >> 5) & 7, b = it >> 8;
        const size_t lat0 = (size_t)(NCTX + b * 4096);
        att::DKV sa, sb;
        sa.k0 = CCK + (size_t)(b * 16 + 2 * h) * 512 * 128; sa.k1 = sa.k0 + 512 * 128; sa.v = CCV + (size_t)(b * 8 + h) * 512 * 256; sa.ldk = 128; sa.ldv = 256; sa.nt = 8;
        sb.k0 = QKV + lat0 * INC + 2048 + 2 * h * 128; sb.k1 = sb.k0 + 128; sb.v = QKV + lat0 * INC + 4096 + h * 256; sb.ldk = INC; sb.ldv = INC; sb.nt = 64;
        att::attn_diff_body(QKV + (lat0 + qb * 128) * INC + 2 * h * 128, INC, sa, sb, AO + (lat0 + qb * 128) * DM + h * 256, DM, (LAS char*)lds, lam, a.in[24]);
    }
    for (int it = vcu; it < 256; it += G) {
        const int qb = it & 1, h = (it >> 1) & 7, b = it >> 4; const size_t r0 = (size_t)b * 256;
        att::DKV sa, sb;
        sa.k0 = QKV + r0 * INC + 2048 + 2 * h * 128; sa.k1 = sa.k0 + 128; sa.v = QKV + r0 * INC + 4096 + h * 256; sa.ldk = INC; sa.ldv = INC; sa.nt = 4;
        sb = sa; sb.nt = 0;
        att::attn_diff_body(QKV + (r0 + qb * 128) * INC + 2 * h * 128, INC, sa, sb, AO + (r0 + qb * 128) * DM + h * 256, DM, (LAS char*)lds, lam, a.in[24]);
    }
}
constexpr int N_PHASES = 22;
#ifndef PHM
#define PHM 0xffff
#endif
#ifndef REPM
#define REPM 0
#endif
#define NREP(bit) ((REPM & (bit)) ? 2 : 1)
__global__ void __launch_bounds__(512, 2) mk_fwd(Args a) {
    LAS unsigned char* lds = (LAS unsigned char*)mk_lds;
    { const unsigned slot = (unsigned)__builtin_amdgcn_s_getreg(((6 - 1) << 11) | 4) & 63u; if ((threadIdx.x & 63) == 0) ((LAS int*)(lds + WTAB_OFF))[slot] = (int)(threadIdx.x >> 6); }
    __syncthreads();
    const int tid = TIDX();
    const int G = gridDim.x, bx = blockIdx.x; const int vcu = (G % 8 == 0) ? (bx % 8) * (G / 8) + bx / 8 : bx;
    volatile LAS unsigned* MISC = (volatile LAS unsigned*)(lds + MISC_OFF);
    if (tid < 32) MISC[tid] = 0u;
    __syncthreads();
    const int lo = a.ph_lo, hi = a.ph_hi;
    unsigned* ctl = (unsigned*)(a.ws + WS_CTL);
    XcdBarrier bar; bar.bar = ctl + CW_BAR; bar.x = 0; bar.st = MISC + 8;
    if (hi - lo > 1) bar = xcd_barrier_post(ctl + CW_BAR, MISC + 8);
    int ph = 0;
#define RUN() (ph >= lo && ph < hi)
#ifndef SEAM_REP
#define SEAM_REP 1
#endif
#define SEAM() do { if (ph >= lo && ph + 1 < hi) { for (int sr_ = 0; sr_ < SEAM_REP; ++sr_) xcd_barrier(bar); } ++ph; } while (0)
    unsigned char* ws = a.ws;
    bf16_t* X = (bf16_t*)(ws + WS_X);
    const float* MODV = (const float*)(ws + WS_MOD);

    if ((PHM & 1) && RUN()) for (int rep = 0; rep < NREP(1); ++rep) phase_prologue(a, lds, vcu, G);
    SEAM();
    for (int s = 0; s < 4; ++s) {
        const int l = s >> 1, half = s & 1, li = s, first = (s == 0);
        if ((PHM & 2) && RUN()) for (int rep = 0; rep < NREP(2); ++rep) { if (first) phase_norm_tiled<true>(a, lds, vcu, G, l, 0); else phase_norm_tiled<false>(a, lds, vcu, G, l, half ? 2 : 0); }
        SEAM();
        if ((PHM & 4) && RUN()) for (int rep = 0; rep < NREP(4); ++rep) { pg8::Gemm g{(const bf16_t*)(ws + WS_H), (const bf16_t*)(ws + WS_W13 + (size_t)li * W13_BYTES), MTOK, 2 * DFF, DM, 1};
            pg8::StaticOrder S; S.init(MTOK, 2 * DFF, DM, G, bx, WGM_UP); EpiSwiglu E{(bf16_t*)(ws + WS_U)};
            pg8::gemm_phase<EpiSwiglu, pg8::StaticOrder, true, true>(lds, g, S, E); }
        SEAM();
        if ((PHM & 8) && RUN()) for (int rep = 0; rep < NREP(8); ++rep) { pg8::Gemm g{(const bf16_t*)(ws + WS_U), (const bf16_t*)(ws + WS_W2 + (size_t)li * W2_BYTES), MTOK, DM, DFF, 1};
            pg8::DnOrder S; S.init(DFF, bx);
            EpiResid E{a.in[0], a.in[1], X, MODV + (size_t)l * 5 * 18432 + (size_t)(half ? 8 : 2) * DM, 0.5f / NREP(8), rep == 0 ? first : 0};
            pg8::gemm_phase<EpiResid, pg8::DnOrder, true, true>(lds, g, S, E);
            pg8::DnHalfOrder Sh; Sh.init(DFF, bx);
            EpiResidT<1> Eh{a.in[0], a.in[1], X, MODV + (size_t)l * 5 * 18432 + (size_t)(half ? 8 : 2) * DM, 0.5f / NREP(8), rep == 0 ? first : 0};
            pg8::gemm_phase<EpiResidT<1>, pg8::DnHalfOrder, true, true, 1>(lds, g, Sh, Eh); }
        SEAM();
        if (half == 0) {
            if ((PHM & 2) && RUN()) for (int rep = 0; rep < NREP(2); ++rep) phase_norm_tiled<false>(a, lds, vcu, G, l, 1);
            SEAM();
            if (l == 0) {
                if ((PHM & 16) && RUN()) for (int rep = 0; rep < NREP(16); ++rep) { pg8::Gemm g{(const bf16_t*)(ws + WS_H), (const bf16_t*)(ws + WS_WINA), MTOK, INA, DM, 1};
                    pg8::StaticOrder S; S.init(MTOK, INA, DM, G, bx, WGM_UP); S.lim = 6 * G; EpiQkvEven E{(bf16_t*)(ws + WS_U), a.out + OUT_AK, a.out + OUT_AV};
                    pg8::gemm_phase<EpiQkvEven, pg8::StaticOrder, true, true>(lds, g, S, E);
                    pg8::HalfOrder Sh; Sh.init(MTOK, INA, DM, G, bx, 6 * G, WGM_UP); EpiQkvEvenT<1> Eh{(bf16_t*)(ws + WS_U), a.out + OUT_AK, a.out + OUT_AV};
                    pg8::gemm_phase<EpiQkvEvenT<1>, pg8::HalfOrder, true, true, 1>(lds, g, Sh, Eh); }
                SEAM();
                if ((PHM & 32) && RUN()) for (int rep = 0; rep < NREP(32); ++rep) phase_mix_even(a, lds, vcu, G);
                SEAM();
            } else {
                if ((PHM & 64) && RUN()) for (int rep = 0; rep < NREP(64); ++rep) { pg8::Gemm g{(const bf16_t*)(ws + WS_H), (const bf16_t*)(ws + WS_WINC), MTOK, INC, DM, 1};
                    pg8::StaticOrder S; S.init(MTOK, INC, DM, G, bx, WGM_UP);
                    EpiQkvOdd E{(bf16_t*)(ws + WS_U), a.out + OUT_CK, a.out + OUT_CV, (const float*)(ws + WS_ROPE), (const float*)(ws + WS_ROPE) + 2048};
                    pg8::gemm_phase<EpiQkvOdd, pg8::StaticOrder, true, true>(lds, g, S, E); }
                SEAM();
                if ((PHM & 128) && RUN()) for (int rep = 0; rep < NREP(128); ++rep) phase_mix_odd(a, lds, vcu, G);
                SEAM();
            }
            if ((PHM & 512) && RUN()) for (int rep = 0; rep < NREP(512); ++rep) { pg8::Gemm g{(const bf16_t*)(ws + WS_AO), (const bf16_t*)(ws + (l == 0 ? WS_WOA : WS_WOC)), MTOK, DM, DM, 0};
                pg8::DnOrder S; S.init(DM, bx);
                EpiResid E{a.in[0], a.in[1], X, MODV + (size_t)l * 5 * 18432 + (size_t)5 * DM, 1.0f / NREP(512), 0};
                pg8::gemm_phase<EpiResid, pg8::DnOrder, true, true>(lds, g, S, E);
                pg8::DnHalfOrder Sh; Sh.init(DM, bx);
                EpiResidT<1> Eh{a.in[0], a.in[1], X, MODV + (size_t)l * 5 * 18432 + (size_t)5 * DM, 1.0f / NREP(512), 0};
                pg8::gemm_phase<EpiResidT<1>, pg8::DnHalfOrder, true, true, 1>(lds, g, Sh, Eh); }
            SEAM();
        }
    }
    if ((PHM & 1024) && RUN()) for (int rep = 0; rep < NREP(1024); ++rep) phase_final(a, vcu, G);
#undef RUN
#undef SEAM
}

extern "C" void kernel_launch(void* const* d_in, const int* in_sizes, int n_in, void* d_out, int out_size, void* d_ws, size_t ws_size, hipStream_t stream) {
    static int grid = 0;
    if (grid == 0) {
        if (n_in != 26 || ws_size < WS_END || out_size != 67108864) { fprintf(stderr, "kernel_launch: unexpected shapes: n_in %d out %d ws %zu (need %zu)\n", n_in, out_size, ws_size, (size_t)WS_END); grid = -1; return; }
        int dev = 0, cus = 0, per_cu = 0;
        if (hipGetDevice(&dev) != hipSuccess || hipDeviceGetAttribute(&cus, hipDeviceAttributeMultiprocessorCount, dev) != hipSuccess) { grid = -1; return; }
        if (hipFuncSetAttribute((const void*)mk_fwd, hipFuncAttributeMaxDynamicSharedMemorySize, LDS_BYTES) != hipSuccess) { fprintf(stderr, "kernel_launch: hipFuncSetAttribute failed\n"); grid = -1; return; }
        if (hipOccupancyMaxActiveBlocksPerMultiprocessor(&per_cu, (const void*)mk_fwd, 512, LDS_BYTES) != hipSuccess || per_cu < 1) fprintf(stderr, "kernel_launch: occupancy query says %d\n", per_cu);
        (void)hipGetLastError();
        grid = cus;
        if (cus != 256) { fprintf(stderr, "kernel_launch: built for a 256-CU device (got %d)\n", cus); grid = -1; return; }
    }
    if (grid < 0) return;
    (void)hipMemsetAsync((char*)d_ws + WS_CTL, 0, CTL_BYTES, stream);
    Args a{};
    for (int i = 0; i < 26; ++i) a.in[i] = (const float*)d_in[i];
    a.out = (float*)d_out; a.ws = (unsigned char*)d_ws;
#if MK_SPLIT
    for (int p = 0; p < N_PHASES; ++p) { a.ph_lo = p; a.ph_hi = p + 1; hipLaunchKernelGGL(mk_fwd, dim3(grid), dim3(512), LDS_BYTES, stream, a); }
#else
    a.ph_lo = 0; a.ph_hi = N_PHASES; hipLaunchKernelGGL(mk_fwd, dim3(grid), dim3(512), LDS_BYTES, stream, a);
#endif
    const hipError_t le = hipPeekAtLastError();
    if (le != hipSuccess) fprintf(stderr, "kernel_launch: launch failed: %s\n", hipGetErrorName(le));
}
```
